# Optimizing an MI355X kernel written in HIP

```python
import jax, jax.numpy as jnp
from jax import lax
import numpy as np

D_MODEL = 1024
BATCH = 4
SEQ = 4096
DEPTH = 1

N_META = 16
NORM_EPS = 1e-6
M_HEADS = 4
M_V = 2 * D_MODEL
M_V_HEAD = M_V // M_HEADS
M_QK_HEAD = M_V_HEAD // 2
M_QK = M_HEADS * M_QK_HEAD
CHUNK = 64
GATE_SOFTCAP = 15.0
S_WIDTH = 2 * D_MODEL
CONV_W = 3
IN_SPLITS = (M_QK, M_QK, M_V, M_V, M_V, M_HEADS, M_HEADS,
             S_WIDTH, S_WIDTH, S_WIDTH, S_WIDTH, D_MODEL, D_MODEL)
N_IN = 2 * M_QK + 3 * M_V + 2 * M_HEADS + 4 * S_WIDTH + 2 * D_MODEL

kernel_name = "meta_mlstm_shortconv_gated_hybrid"


def rmsnorm(x, w):
    xf = x.astype(jnp.float32)
    y = xf * lax.rsqrt(jnp.mean(xf * xf, axis=-1, keepdims=True) + NORM_EPS)
    return (y * w.astype(jnp.float32)).astype(x.dtype)


def softcap(x, cap):
    return cap * jnp.tanh(x / cap)


def causal_depthwise_conv(u, w):
    k, c = w.shape
    return lax.conv_general_dilated(
        u, w[:, None, :].astype(u.dtype), window_strides=(1,), padding=[(k - 1, 0)],
        dimension_numbers=("NWC", "WIO", "NWC"), feature_group_count=c)


def mlstm_chunkwise(q, k, v, li, lf):
    bsz, seq_len, n_heads, dk = q.shape
    dv = v.shape[-1]
    pad = CHUNK - N_META

    def padt(a, val):
        return jnp.pad(a, [(0, 0), (pad, 0)] + [(0, 0)] * (a.ndim - 2), constant_values=val)

    q = padt(q * (dk ** -0.5), 0.0)
    k = padt(k, 0.0)
    v = padt(v, 0.0)
    lf = padt(lf, 0.0)
    li = padt(li, -jnp.inf)
    n_chunks = (seq_len + pad) // CHUNK

    def to_chunks(a):
        a = a.reshape((bsz, n_chunks, CHUNK) + a.shape[2:])
        return jnp.moveaxis(a, (1, 3), (0, 2))

    xs = tuple(to_chunks(a) for a in (q, k, v, li, lf))
    causal = jnp.tril(jnp.ones((CHUNK, CHUNK), dtype=bool))

    def step(carry, inp):
        c_prev, n_prev, m_prev = carry
        qc, kc, vc, lic, lfc = inp
        b = jnp.cumsum(lfc, axis=-1)
        dlog = jnp.where(causal, b[..., :, None] - b[..., None, :] + lic[..., None, :], -jnp.inf)
        inter = b + m_prev[..., None]
        m_t = jnp.maximum(inter, jnp.max(dlog, axis=-1))
        w = jnp.exp(dlog - m_t[..., None]) * jnp.einsum("bhtd,bhsd->bhts", qc, kc)
        wi = jnp.exp(inter - m_t)
        num = (wi[..., None] * jnp.einsum("bhtd,bhde->bhte", qc, c_prev)
               + jnp.einsum("bhts,bhse->bhte", w, vc))
        den = wi * jnp.einsum("bhtd,bhd->bht", qc, n_prev) + jnp.sum(w, axis=-1)
        h = num / jnp.maximum(jnp.abs(den), jnp.exp(-m_t))[..., None]
        b_last = b[..., -1]
        wlog = b_last[..., None] - b + lic
        m_new = jnp.maximum(b_last + m_prev, jnp.max(wlog, axis=-1))
        decay = jnp.exp(b_last + m_prev - m_new)
        kw = jnp.exp(wlog - m_new[..., None])[..., None] * kc
        c_new = decay[..., None, None] * c_prev + jnp.einsum("bhsd,bhse->bhde", kw, vc)
        n_new = decay[..., None] * n_prev + jnp.sum(kw, axis=-2)
        return (c_new, n_new, m_new), h

    init = (jnp.zeros((bsz, n_heads, dk, dv), jnp.float32),
            jnp.zeros((bsz, n_heads, dk), jnp.float32),
            jnp.zeros((bsz, n_heads), jnp.float32))
    _, h = lax.scan(step, init, xs)
    h = jnp.moveaxis(h, (0, 2), (1, 3)).reshape(bsz, n_chunks * CHUNK, n_heads, dv)
    return h[:, pad:]


def hybrid_layer(x, norm_w, w_in, b_igate, b_fgate, mh_norm_w, conv_w,
                 w_proj_a, w_proj_b, w_out):
    bsz, seq_len, _ = x.shape
    f32 = jnp.float32
    xn = rmsnorm(x, norm_w)
    proj = xn @ w_in
    split_at = np.cumsum(IN_SPLITS)[:-1].tolist()
    (q, k, v, o_pre, z_a, i_pre, f_pre,
     s_h, s_b, s_c, z_s, g_a, g_b) = jnp.split(proj, split_at, axis=-1)

    qh = q.reshape(bsz, seq_len, M_HEADS, M_QK_HEAD).astype(f32)
    kh = k.reshape(bsz, seq_len, M_HEADS, M_QK_HEAD).astype(f32)
    vh = v.reshape(bsz, seq_len, M_HEADS, M_V_HEAD).astype(f32)
    li = softcap(i_pre.astype(f32) + b_igate.astype(f32), GATE_SOFTCAP)
    lf = jax.nn.log_sigmoid(softcap(f_pre.astype(f32) + b_fgate.astype(f32), GATE_SOFTCAP))
    h = mlstm_chunkwise(qh, kh, vh, li, lf)
    h = h * lax.rsqrt(jnp.mean(h * h, axis=-1, keepdims=True) + NORM_EPS)
    h = (h.reshape(bsz, seq_len, M_V) * mh_norm_w.astype(f32)).astype(x.dtype)
    a = jax.nn.silu(z_a) * (jax.nn.sigmoid(o_pre) * h)

    y_s = jax.nn.silu(z_s) * (s_b * causal_depthwise_conv(s_c * s_h, conv_w))

    merged = (jax.nn.sigmoid(g_a) * (a @ w_proj_a)
              + jax.nn.sigmoid(g_b) * (y_s @ w_proj_b))
    return x + merged @ w_out


def setup_inputs(seed: int = 0) -> dict:
    key = jax.random.key(seed)
    ks = jax.random.split(key, 13)
    nrm = jax.random.normal
    return {
        "x": nrm(ks[0], (BATCH, SEQ, D_MODEL), jnp.float32),
        "meta_tokens": nrm(ks[1], (N_META, D_MODEL), jnp.float32),
        "norm_w": 1.0 + 0.02 * nrm(ks[2], (DEPTH, D_MODEL), jnp.float32),
        "w_in": nrm(ks[3], (DEPTH, D_MODEL, N_IN), jnp.float32) * D_MODEL ** -0.5,
        "b_igate": 0.1 * nrm(ks[4], (DEPTH, M_HEADS), jnp.float32),
        "b_fgate": jnp.linspace(3.0, 6.0, M_HEADS, dtype=jnp.float32)[None, :]
                   + 0.1 * nrm(ks[5], (DEPTH, M_HEADS), jnp.float32),
        "mh_norm_w": 1.0 + 0.02 * nrm(ks[6], (DEPTH, M_V), jnp.float32),
        "conv_w": nrm(ks[7], (DEPTH, CONV_W, S_WIDTH), jnp.float32) * CONV_W ** -0.5,
        "w_proj_a": nrm(ks[8], (DEPTH, M_V, D_MODEL), jnp.float32) * M_V ** -0.5,
        "w_proj_b": nrm(ks[9], (DEPTH, S_WIDTH, D_MODEL), jnp.float32) * S_WIDTH ** -0.5,
        "w_out": nrm(ks[10], (DEPTH, D_MODEL, D_MODEL), jnp.float32) * D_MODEL ** -0.5,
        "final_norm_w": 1.0 + 0.02 * nrm(ks[11], (D_MODEL,), jnp.float32),
    }


def reference(x, meta_tokens, norm_w, w_in, b_igate, b_fgate, mh_norm_w, conv_w,
              w_proj_a, w_proj_b, w_out, final_norm_w):
    bsz = x.shape[0]
    meta = jnp.broadcast_to(meta_tokens[None].astype(x.dtype), (bsz, N_META, D_MODEL))
    h = jnp.concatenate([meta, x], axis=1)
    for layer in range(DEPTH):
        h = hybrid_layer(h, norm_w[layer], w_in[layer], b_igate[layer], b_fgate[layer],
                         mh_norm_w[layer], conv_w[layer], w_proj_a[layer],
                         w_proj_b[layer], w_out[layer])
    return rmsnorm(h, final_norm_w)[:, N_META:]
```

```cpp
#include <hip/hip_runtime.h>
#include <hip/hip_cooperative_groups.h>
#include <cstdio>
namespace cg = cooperative_groups;

#ifndef SINGLE_LAUNCH
#define SINGLE_LAUNCH 1
#endif

#define LAS __attribute__((address_space(3)))
typedef unsigned short bf16_t;
typedef short bf16x8 __attribute__((ext_vector_type(8)));
typedef float f32x4 __attribute__((ext_vector_type(4)));
typedef unsigned u32x4 __attribute__((ext_vector_type(4)));
typedef unsigned u32x2 __attribute__((ext_vector_type(2)));

constexpr int DM = 1024, NB = 4, SEQ = 4096, LP = 4160, PADL = 48, MP = NB * LP, MC = NB * SEQ, NCH = 65, NIN = 18440, NITEM = 16 * NCH;
constexpr int OFF_O = 4096, OFF_ZA = 6144, OFF_I = 8192, OFF_SH = 8200, OFF_SB = 10248, OFF_SC = 12296, OFF_ZS = 14344, OFF_GA = 16392, OFF_GB = 17416;
constexpr float EPS = 1e-6f;

constexpr size_t SZ_XN = (size_t)MP * 1024 * 2, SZ_WINT = (size_t)18432 * 1024 * 2, SZ_W2 = (size_t)1024 * 2048 * 2, SZ_WO = (size_t)1024 * 1024 * 2;
constexpr size_t SZ_G = (size_t)16 * LP * 4, SZ_C4 = (size_t)MC * 4 * 4;
constexpr size_t WS_XN = 0, WS_WINT = WS_XN + SZ_XN, WS_WAT = WS_WINT + SZ_WINT, WS_WBT = WS_WAT + SZ_W2, WS_WOT = WS_WBT + SZ_W2,
                 WS_LI = WS_WOT + SZ_WO, WS_LF = WS_LI + SZ_G, WS_EMT = WS_LF + SZ_G, WS_DEN = WS_EMT + SZ_G, WS_SC = WS_DEN + SZ_C4,
                 WS_DECAY = WS_SC + SZ_C4, WS_SSQ = WS_DECAY + 4352, WS_R1 = WS_SSQ + (size_t)MC * 16 * 4,
                 WS_R2 = WS_R1 + (size_t)MP * 2048 * 2, WS_R3 = WS_R2 + (size_t)MP * 2048 * 2,
                 SZ_QF = (size_t)NITEM * 16384 * 2, SZ_WF = (size_t)NITEM * 4096 * 2, WS_END = WS_R3 + 2 * SZ_QF + SZ_WF;
static_assert(WS_END <= (size_t)4 * 1024 * 18440 * 4, "workspace budget");
static_assert(WS_R1 % 256 == 0 && WS_R3 % 256 == 0, "align");

struct Args {
    const float* x; const float* meta; const float* norm_w; const float* w_in; const float* b_i; const float* b_f; const float* mh_w;
    const float* conv_w; const float* w_pa; const float* w_pb; const float* w_out; const float* fin_w;
    float* out; unsigned char* ws; int ph_lo, ph_hi;
};

__device__ __forceinline__ unsigned cvt_pk_bf16(float lo, float hi) { unsigned r; asm volatile("v_cvt_pk_bf16_f32 %0, %1, %2" : "=v"(r) : "v"(lo), "v"(hi)); return r; }
__device__ __forceinline__ float bf_lo(unsigned w) { return __uint_as_float(w << 16); }
__device__ __forceinline__ float bf_hi(unsigned w) { return __uint_as_float(w & 0xffff0000u); }
__device__ __forceinline__ float bf2f(bf16_t b) { return __uint_as_float(((unsigned)b) << 16); }
__device__ __forceinline__ float sigm(float x) { return 1.0f / (1.0f + __expf(-x)); }
__device__ __forceinline__ float wave_sum(float v) {
#pragma unroll
    for (int o = 32; o >= 1; o >>= 1) v += __shfl_xor(v, o);
    return v;
}
__device__ __forceinline__ float wave_max(float v) {
#pragma unroll
    for (int o = 32; o >= 1; o >>= 1) v = fmaxf(v, __shfl_xor(v, o));
    return v;
}
__device__ __forceinline__ float wave_scan_add(float v, int lane) {
#pragma unroll
    for (int o = 1; o < 64; o <<= 1) { float t = __shfl_up(v, o); if (lane >= o) v += t; }
    return v;
}
__device__ __forceinline__ float wave_scan_max(float v, int lane) {
#pragma unroll
    for (int o = 1; o < 64; o <<= 1) { float t = __shfl_up(v, o); if (lane >= o) v = fmaxf(v, t); }
    return v;
}

namespace pg8 {
constexpr int BM = 256, BK = 64, HALF = 128, HTB = HALF * BK * 2, STAGE_BYTES = 8 * HTB, NXCD = 8, WGM = 8;
__device__ __forceinline__ int lds_byte(int r, int c) { const int st = (r >> 4) * 2 + (c >> 5), rr = r & 15, cc = c & 31, ob = rr * 64 + cc * 2; return st * 1024 + (ob ^ (((ob >> 9) & 1) << 5)); }
__device__ __forceinline__ void stage_rc(int b, int& R, int& C) { const int st = b / 1024, sb = b % 1024, swz = sb ^ (((sb >> 9) & 1) << 5); R = (st >> 1) * 16 + swz / 64; C = (st & 1) * 32 + (swz % 64) / 2; }
__device__ __forceinline__ int perm32(int rho) { const int n = rho >> 4, i = rho & 15; return 8 * (i >> 2) + 4 * n + (i & 3); }
struct Unit { int pm, pn, seg; };

template <class Epi, class Sched>
__device__ __forceinline__ void gemm_phase(LAS unsigned char* lds, const int K, const Sched& S, const Epi& E) {
    const int tid = threadIdx.x, wid = __builtin_amdgcn_readfirstlane(tid >> 6), lane = tid & 63, wr = wid >> 2, wc = wid & 3, fr = lane & 15, fq = lane >> 4;
    const int nt = K / BK;
    unsigned voffA[2], voffB[2];
#pragma unroll
    for (int i = 0; i < 2; ++i) { int R, C; stage_rc(tid * 16 + i * 8192, R, C); const int Rb = Epi::PERM ? ((R & ~31) + perm32(R & 31)) : R;
        voffA[i] = (unsigned)(R * K + C) * 2u; voffB[i] = (unsigned)(Rb * K + C) * 2u; }
    const size_t kstep = (size_t)(BK * 2);
    const size_t hstep = (size_t)HALF * K * 2;
    const unsigned ldsw = (unsigned)wid * 1024u;
    const int aoff = lds_byte(wr * 64 + fr, fq * 8), boff = lds_byte(wc * 32 + fr, fq * 8);
#define PG8_SA(b, h) (((b) * 2 + (h)) * HTB)
#define PG8_SB(b, h) ((4 + (b) * 2 + (h)) * HTB)
#define PG8_STAGE(bufoff, gbase, voff) do { _Pragma("unroll") for (int _i = 0; _i < 2; ++_i) \
        __builtin_amdgcn_global_load_lds((const unsigned*)((const char*)(gbase) + (voff)[_i]), (LAS unsigned*)(lds + (bufoff) + ldsw + _i * 8192), 16, 0, 0); } while (0)
#define PG8_LDA(dst, b, h) do { _Pragma("unroll") for (int m = 0; m < 4; ++m) _Pragma("unroll") for (int k = 0; k < 2; ++k) dst[m][k] = *(const LAS bf16x8*)(lds + PG8_SA(b, h) + aoff + m * 2048 + k * 1024); } while (0)
#define PG8_LDB(dst, b, h) do { _Pragma("unroll") for (int n = 0; n < 2; ++n) _Pragma("unroll") for (int k = 0; k < 2; ++k) dst[n][k] = *(const LAS bf16x8*)(lds + PG8_SB(b, h) + boff + n * 2048 + k * 1024); } while (0)
#define PG8_MMA(ai, bj, At, Bt) do { __builtin_amdgcn_s_setprio(1); _Pragma("unroll") for (int m = 0; m < 4; ++m) _Pragma("unroll") for (int n = 0; n < 2; ++n) _Pragma("unroll") for (int k = 0; k < 2; ++k) \
        acc[ai][bj][m][n] = __builtin_amdgcn_mfma_f32_16x16x32_bf16(Bt[n][k], At[m][k], acc[ai][bj][m][n], 0, 0, 0); __builtin_amdgcn_s_setprio(0); } while (0)
#define PG8_WAIT_V(n) asm volatile("s_waitcnt vmcnt(" #n ")" ::: "memory")
#define PG8_WAIT_L(n) asm volatile("s_waitcnt lgkmcnt(" #n ")" ::: "memory")
#define PG8_BAR __builtin_amdgcn_s_barrier()
#define PG8_SCHED __builtin_amdgcn_sched_barrier(0)
    Unit cur, nxt; int ui = 0;
    if (!S.next(0, cur)) return;
    f32x4 acc[2][2][4][2];
#pragma unroll
    for (int a = 0; a < 2; ++a)
#pragma unroll
        for (int b = 0; b < 2; ++b)
#pragma unroll
            for (int m = 0; m < 4; ++m)
#pragma unroll
                for (int n = 0; n < 2; ++n) acc[a][b][m][n] = (f32x4){0.f, 0.f, 0.f, 0.f};
    bf16x8 At[4][2], B0[2][2], B1[2][2];
    const char* cA = S.abase(cur); const char* cB = S.bbase(cur);
    PG8_STAGE(PG8_SB(0, 0), cB, voffB); PG8_STAGE(PG8_SA(0, 0), cA, voffA); PG8_STAGE(PG8_SB(0, 1), cB + hstep, voffB); PG8_STAGE(PG8_SA(0, 1), cA + hstep, voffA);
    if (wr == 1) PG8_BAR;
    PG8_WAIT_V(4); PG8_BAR;
    PG8_STAGE(PG8_SB(1, 0), cB + kstep, voffB); PG8_STAGE(PG8_SA(1, 0), cA + kstep, voffA); PG8_STAGE(PG8_SB(1, 1), cB + hstep + kstep, voffB);
    PG8_WAIT_V(6); PG8_BAR;
    for (;;) {
        const bool has_next = S.next(ui + 1, nxt);
        const char* nA = has_next ? S.abase(nxt) : cA; const char* nB = has_next ? S.bbase(nxt) : cB;
        for (int t = 0; t < nt; t += 2) {
            const bool last = (t == nt - 2);
            const char* a1 = cA + (size_t)(t + 1) * kstep;
            const char* a2 = last ? nA : cA + (size_t)(t + 2) * kstep; const char* b2 = last ? nB : cB + (size_t)(t + 2) * kstep;
            const char* a3 = a2 + kstep; const char* b3 = b2 + kstep;
            PG8_LDB(B0, 0, 0); PG8_SCHED; PG8_LDA(At, 0, 0); PG8_STAGE(PG8_SA(1, 1), a1 + hstep, voffA);
            PG8_WAIT_L(8); PG8_BAR; PG8_WAIT_L(0); PG8_MMA(0, 0, At, B0); PG8_BAR; PG8_SCHED;
            PG8_LDB(B1, 0, 1); PG8_STAGE(PG8_SB(0, 0), b2, voffB);
            PG8_BAR; PG8_WAIT_L(0); PG8_MMA(0, 1, At, B1); PG8_BAR;
            PG8_LDA(At, 0, 1); PG8_STAGE(PG8_SA(0, 0), a2, voffA);
            PG8_BAR; PG8_WAIT_L(0); PG8_MMA(1, 0, At, B0); PG8_BAR; PG8_SCHED;
            PG8_STAGE(PG8_SB(0, 1), b2 + hstep, voffB);
            PG8_WAIT_V(6); PG8_BAR; PG8_MMA(1, 1, At, B1); PG8_BAR;
            PG8_LDB(B0, 1, 0); PG8_SCHED; PG8_LDA(At, 1, 0); PG8_STAGE(PG8_SA(0, 1), a2 + hstep, voffA);
            PG8_WAIT_L(8); PG8_BAR; PG8_WAIT_L(0); PG8_MMA(0, 0, At, B0); PG8_BAR; PG8_SCHED;
            PG8_LDB(B1, 1, 1); PG8_STAGE(PG8_SB(1, 0), b3, voffB);
            PG8_BAR; PG8_WAIT_L(0); PG8_MMA(0, 1, At, B1); PG8_BAR;
            PG8_LDA(At, 1, 1); PG8_STAGE(PG8_SA(1, 0), a3, voffA);
            PG8_BAR; PG8_WAIT_L(0); PG8_MMA(1, 0, At, B0); PG8_BAR; PG8_SCHED;
            PG8_STAGE(PG8_SB(1, 1), b3 + hstep, voffB);
            PG8_WAIT_V(6); PG8_BAR; PG8_MMA(1, 1, At, B1); PG8_BAR;
        }
        E(acc, cur, wr, wc, fr, fq);
        if (!has_next) break;
        if (E.zero_after(cur)) {
#pragma unroll
            for (int a = 0; a < 2; ++a)
#pragma unroll
                for (int b = 0; b < 2; ++b)
#pragma unroll
                    for (int m = 0; m < 4; ++m)
#pragma unroll
                        for (int n = 0; n < 2; ++n) acc[a][b][m][n] = (f32x4){0.f, 0.f, 0.f, 0.f};
        }
        cur = nxt; cA = nA; cB = nB; ++ui;
    }
    PG8_WAIT_V(0);
    if (wr == 0) PG8_BAR;
    PG8_BAR;
#undef PG8_SA
#undef PG8_SB
#undef PG8_STAGE
#undef PG8_LDA
#undef PG8_LDB
#undef PG8_MMA
#undef PG8_WAIT_V
#undef PG8_WAIT_L
#undef PG8_BAR
#undef PG8_SCHED
}
}
using pg8::Unit;

struct SchedIn {
    int nN, pnoff, G, c; const char* A; const char* B;
    __device__ __forceinline__ bool next(int i, Unit& u) const {
        const int nM = 65, nwg = nM * nN; const long L = (long)i * G + c; if (L >= nwg) return false;
        int wgid = (int)L; { const int q = nwg / 8, r = nwg % 8, xcd = wgid % 8, off = wgid / 8; wgid = (xcd < r ? xcd * (q + 1) : r * (q + 1) + (xcd - r) * q) + off; }
        const int nig = 8 * nN, gid = wgid / nig, fm = gid * 8, gsz = (nM - fm) < 8 ? (nM - fm) : 8;
        u.pm = fm + ((wgid % nig) % gsz); u.pn = pnoff + (wgid % nig) / gsz; u.seg = 0; return true;
    }
    __device__ __forceinline__ const char* abase(const Unit& u) const { return A + (size_t)u.pm * (256 * 1024 * 2); }
    __device__ __forceinline__ const char* bbase(const Unit& u) const { return B + (size_t)u.pn * (256 * 1024 * 2); }
};
struct SchedMerge {
    int G, c; const char* A0; const char* A1; const char* B0; const char* B1;
    __device__ __forceinline__ bool next(int i, Unit& u) const {
        const int tile = (i >> 1) * G + c; if (tile >= 256) return false;
        u.pm = tile >> 2; u.pn = tile & 3; u.seg = i & 1; return true;
    }
    __device__ __forceinline__ const char* abase(const Unit& u) const { return (u.seg ? A1 : A0) + (size_t)u.pm * (256 * 2048 * 2); }
    __device__ __forceinline__ const char* bbase(const Unit& u) const { return (u.seg ? B1 : B0) + (size_t)u.pn * (256 * 2048 * 2); }
};
struct SchedOut {
    int G, c; const char* A; const char* B;
    __device__ __forceinline__ bool next(int i, Unit& u) const {
        const int tile = i * G + c; if (tile >= 256) return false;
        u.pm = tile >> 2; u.pn = tile & 3; u.seg = 0; return true;
    }
    __device__ __forceinline__ const char* abase(const Unit& u) const { return A + (size_t)u.pm * (256 * 1024 * 2); }
    __device__ __forceinline__ const char* bbase(const Unit& u) const { return B + (size_t)u.pn * (256 * 1024 * 2); }
};

struct EpiQKV {
    static constexpr bool PERM = true;
    bf16_t* QB; bf16_t* KB; bf16_t* VB;
    __device__ __forceinline__ bool zero_after(const Unit&) const { return true; }
    __device__ __forceinline__ void operator()(f32x4 (&acc)[2][2][4][2], const Unit& u, int wr, int wc, int fr, int fq) const {
        bf16_t* base; int ldc, colt; float sc = 1.f;
        if (u.pn < 4) { base = QB; ldc = 1024; colt = u.pn * 256; sc = 0.0625f; }
        else if (u.pn < 8) { base = KB; ldc = 1024; colt = (u.pn - 4) * 256; }
        else { base = VB; ldc = 2048; colt = (u.pn - 8) * 256; }
        const int row0 = u.pm * 256 + wr * 64 + fr, col0 = colt + wc * 32 + 8 * fq;
#pragma unroll
        for (int ai = 0; ai < 2; ++ai)
#pragma unroll
            for (int m = 0; m < 4; ++m) { bf16_t* rowp = base + (size_t)(row0 + ai * 128 + m * 16) * ldc + col0;
#pragma unroll
                for (int bj = 0; bj < 2; ++bj) { const f32x4 v0 = acc[ai][bj][m][0] * sc, v1 = acc[ai][bj][m][1] * sc;
                    u32x4 w; w.x = cvt_pk_bf16(v0[0], v0[1]); w.y = cvt_pk_bf16(v0[2], v0[3]); w.z = cvt_pk_bf16(v1[0], v1[1]); w.w = cvt_pk_bf16(v1[2], v1[3]);
                    *(u32x4*)(rowp + bj * 128) = w; } }
    }
};
struct EpiRest {
    static constexpr bool PERM = true;
    bf16_t* HN; const float* SC; const float* mhw; bf16_t* U; bf16_t* GS; bf16_t* GG;
    __device__ __forceinline__ bool zero_after(const Unit&) const { return true; }
    __device__ __forceinline__ void operator()(f32x4 (&acc)[2][2][4][2], const Unit& u, int wr, int wc, int fr, int fq) const {
        const int row0 = u.pm * 256 + wr * 64 + fr; const int cw = wc * 32 + 8 * fq;
        if (u.pn >= 64) {
            const int col0 = (u.pn - 64) * 256 + cw;
#pragma unroll
            for (int ai = 0; ai < 2; ++ai)
#pragma unroll
                for (int m = 0; m < 4; ++m) { const int r = row0 + ai * 128 + m * 16, b = r / LP, p = r - b * LP; if (p < 64) continue;
                    bf16_t* rowp = GG + (size_t)(b * SEQ + p - 64) * 2048 + col0;
#pragma unroll
                    for (int bj = 0; bj < 2; ++bj) { const f32x4 v0 = acc[ai][bj][m][0], v1 = acc[ai][bj][m][1];
                        u32x4 w; w.x = cvt_pk_bf16(v0[0], v0[1]); w.y = cvt_pk_bf16(v0[2], v0[3]); w.z = cvt_pk_bf16(v1[0], v1[1]); w.w = cvt_pk_bf16(v1[2], v1[3]);
                        *(u32x4*)(rowp + bj * 128) = w; } }
            return;
        }
        const int kind = (u.pn - 16) >> 4, ch0 = ((u.pn - 16) & 15) * 128 + cw;
        float mw[8];
        if (kind == 0) {
#pragma unroll
            for (int j = 0; j < 8; ++j) mw[j] = mhw[ch0 + j];
        }
#pragma unroll
        for (int ai = 0; ai < 2; ++ai)
#pragma unroll
            for (int m = 0; m < 4; ++m) {
                const int r = row0 + ai * 128 + m * 16, b = r / LP, p = r - b * LP; const size_t cr = (size_t)(b * SEQ + p - 64);
                float v[8];
                if (kind == 0) {
                    if (p < 64) continue;
                    const u32x4 hn = *(const u32x4*)(HN + cr * 2048 + ch0); const float sc = SC[cr * 4 + (ch0 >> 9)];
                    const float hv[8] = {bf_lo(hn.x), bf_hi(hn.x), bf_lo(hn.y), bf_hi(hn.y), bf_lo(hn.z), bf_hi(hn.z), bf_lo(hn.w), bf_hi(hn.w)};
#pragma unroll
                    for (int j = 0; j < 8; ++j) { const float o = acc[ai][0][m][j >> 2][j & 3], z = acc[ai][1][m][j >> 2][j & 3]; v[j] = z * sigm(z) * sigm(o) * (hv[j] * sc * mw[j]); }
                    u32x4 w; w.x = cvt_pk_bf16(v[0], v[1]); w.y = cvt_pk_bf16(v[2], v[3]); w.z = cvt_pk_bf16(v[4], v[5]); w.w = cvt_pk_bf16(v[6], v[7]);
                    *(u32x4*)(HN + cr * 2048 + ch0) = w;
                } else if (kind == 1) {
#pragma unroll
                    for (int j = 0; j < 8; ++j) v[j] = acc[ai][0][m][j >> 2][j & 3] * acc[ai][1][m][j >> 2][j & 3];
                    u32x4 w; w.x = cvt_pk_bf16(v[0], v[1]); w.y = cvt_pk_bf16(v[2], v[3]); w.z = cvt_pk_bf16(v[4], v[5]); w.w = cvt_pk_bf16(v[6], v[7]);
                    *(u32x4*)(U + (size_t)r * 2048 + ch0) = w;
                } else {
                    if (p < 64) continue;
#pragma unroll
                    for (int j = 0; j < 8; ++j) { const float sb = acc[ai][0][m][j >> 2][j & 3], z = acc[ai][1][m][j >> 2][j & 3]; v[j] = z * sigm(z) * sb; }
                    u32x4 w; w.x = cvt_pk_bf16(v[0], v[1]); w.y = cvt_pk_bf16(v[2], v[3]); w.z = cvt_pk_bf16(v[4], v[5]); w.w = cvt_pk_bf16(v[6], v[7]);
                    *(u32x4*)(GS + cr * 2048 + ch0) = w;
                }
            }
    }
};
struct EpiMerge {
    static constexpr bool PERM = true;
    const bf16_t* GG; bf16_t* MG;
    __device__ __forceinline__ bool zero_after(const Unit& u) const { return u.seg == 1; }
    __device__ __forceinline__ void operator()(f32x4 (&acc)[2][2][4][2], const Unit& u, int wr, int wc, int fr, int fq) const {
        const int row0 = u.pm * 256 + wr * 64 + fr, col0 = u.pn * 256 + wc * 32 + 8 * fq;
#pragma unroll
        for (int ai = 0; ai < 2; ++ai)
#pragma unroll
            for (int m = 0; m < 4; ++m) { const size_t cr = (size_t)(row0 + ai * 128 + m * 16);
#pragma unroll
                for (int bj = 0; bj < 2; ++bj) {
                    const u32x4 ga = *(const u32x4*)(GG + cr * 2048 + col0 + bj * 128), gb = *(const u32x4*)(GG + cr * 2048 + 1024 + col0 + bj * 128);
                    const float gav[8] = {bf_lo(ga.x), bf_hi(ga.x), bf_lo(ga.y), bf_hi(ga.y), bf_lo(ga.z), bf_hi(ga.z), bf_lo(ga.w), bf_hi(ga.w)};
                    const float gbv[8] = {bf_lo(gb.x), bf_hi(gb.x), bf_lo(gb.y), bf_hi(gb.y), bf_lo(gb.z), bf_hi(gb.z), bf_lo(gb.w), bf_hi(gb.w)};
                    if (u.seg == 0) {
#pragma unroll
                        for (int j = 0; j < 8; ++j) acc[ai][bj][m][j >> 2][j & 3] *= sigm(gav[j]) / fmaxf(sigm(gbv[j]), 1e-30f);
                    } else {
                        float v[8];
#pragma unroll
                        for (int j = 0; j < 8; ++j) v[j] = acc[ai][bj][m][j >> 2][j & 3] * fmaxf(sigm(gbv[j]), 1e-30f);
                        u32x4 w; w.x = cvt_pk_bf16(v[0], v[1]); w.y = cvt_pk_bf16(v[2], v[3]); w.z = cvt_pk_bf16(v[4], v[5]); w.w = cvt_pk_bf16(v[6], v[7]);
                        *(u32x4*)(MG + cr * 1024 + col0 + bj * 128) = w;
                    }
                } }
    }
};
struct EpiOut {
    static constexpr bool PERM = false;
    const float* x; float* out; float* SSQ;
    __device__ __forceinline__ bool zero_after(const Unit&) const { return true; }
    __device__ __forceinline__ void operator()(f32x4 (&acc)[2][2][4][2], const Unit& u, int wr, int wc, int fr, int fq) const {
        const int row0 = u.pm * 256 + wr * 64 + fr, col0 = u.pn * 256 + wc * 32 + 4 * fq;
#pragma unroll
        for (int ai = 0; ai < 2; ++ai)
#pragma unroll
            for (int m = 0; m < 4; ++m) { const size_t cr = (size_t)(row0 + ai * 128 + m * 16); float ss = 0.f;
#pragma unroll
                for (int bj = 0; bj < 2; ++bj)
#pragma unroll
                    for (int n = 0; n < 2; ++n) { const size_t o = cr * 1024 + col0 + bj * 128 + n * 16;
                        const f32x4 h = *(const f32x4*)(x + o) + acc[ai][bj][m][n]; *(f32x4*)(out + o) = h;
                        ss += (h[0] * h[0] + h[1] * h[1]) + (h[2] * h[2] + h[3] * h[3]); }
                ss += __shfl_xor(ss, 16); ss += __shfl_xor(ss, 32);
                if (fq == 0) SSQ[cr * 16 + u.pn * 4 + wc] = ss; }
    }
};

__device__ __forceinline__ int win_col(int np) {
    const int pn = np >> 8, l = np & 255, bj = l >> 7, w = l & 127;
    if (pn < 16) return np;
    if (pn < 32) return (bj ? OFF_ZA : OFF_O) + 128 * (pn - 16) + w;
    if (pn < 48) return (bj ? OFF_SC : OFF_SH) + 128 * (pn - 32) + w;
    if (pn < 64) return (bj ? OFF_ZS : OFF_SB) + 128 * (pn - 48) + w;
    if (pn < 68) return OFF_GA + 256 * (pn - 64) + l;
    return OFF_GB + 256 * (pn - 68) + l;
}
__device__ void phase_prep(LAS unsigned char* lds, const Args& a) {
    const int tid = threadIdx.x, wid = tid >> 6, lane = tid & 63;
    LAS float* tile = (LAS float*)lds;
    LAS float* wg = (LAS float*)(lds + 64 * 65 * 4);
    bf16_t* WINT = (bf16_t*)(a.ws + WS_WINT); bf16_t* WAT = (bf16_t*)(a.ws + WS_WAT); bf16_t* WBT = (bf16_t*)(a.ws + WS_WBT); bf16_t* WOT = (bf16_t*)(a.ws + WS_WOT);
    for (int job = blockIdx.x; job < 5888; job += gridDim.x) {
        const float* src; bf16_t* dst; int lds_, col0, n0, k0, Kd;
        if (job < 4608) { const int jn = job >> 4, jk = job & 15; n0 = jn * 64; k0 = jk * 64; src = a.w_in; lds_ = NIN; col0 = win_col(n0); dst = WINT; Kd = 1024; }
        else if (job < 5632) { const int j = job - 4608, which = j >> 9, jj = j & 511, jn = jj >> 5, jk = jj & 31; n0 = jn * 64; k0 = jk * 64; src = which ? a.w_pb : a.w_pa; lds_ = 1024; col0 = n0; dst = which ? WBT : WAT; Kd = 2048; }
        else { const int j = job - 5632, jn = j >> 4, jk = j & 15; n0 = jn * 64; k0 = jk * 64; src = a.w_out; lds_ = 1024; col0 = n0; dst = WOT; Kd = 1024; }
#pragma unroll
        for (int i = 0; i < 2; ++i) { const int idx = tid + 512 * i, kr = idx >> 4, c4 = idx & 15;
            const f32x4 v = *(const f32x4*)(src + (size_t)(k0 + kr) * lds_ + col0 + 4 * c4);
            tile[kr * 65 + 4 * c4 + 0] = v[0]; tile[kr * 65 + 4 * c4 + 1] = v[1]; tile[kr * 65 + 4 * c4 + 2] = v[2]; tile[kr * 65 + 4 * c4 + 3] = v[3]; }
        __syncthreads();
        { const int n = tid >> 3, seg = tid & 7; float f[8];
#pragma unroll
          for (int j = 0; j < 8; ++j) f[j] = tile[(8 * seg + j) * 65 + n];
          u32x4 w; w.x = cvt_pk_bf16(f[0], f[1]); w.y = cvt_pk_bf16(f[2], f[3]); w.z = cvt_pk_bf16(f[4], f[5]); w.w = cvt_pk_bf16(f[6], f[7]);
          *(u32x4*)(dst + (size_t)(n0 + n) * Kd + k0 + 8 * seg) = w; }
        __syncthreads();
    }
    for (int i = tid; i < 8192; i += 512) wg[i] = a.w_in[(size_t)(i >> 3) * NIN + OFF_I + (i & 7)];
    __syncthreads();
    bf16_t* XN = (bf16_t*)(a.ws + WS_XN); float* LI = (float*)(a.ws + WS_LI); float* LF = (float*)(a.ws + WS_LF);
    for (int r = blockIdx.x * 8 + wid; r < MP; r += gridDim.x * 8) {
        const int b = r / LP, p = r - b * LP;
        if (p < PADL) {
#pragma unroll
            for (int i = 0; i < 4; ++i) *(u32x2*)(XN + (size_t)r * 1024 + 256 * i + 4 * lane) = (u32x2){0u, 0u};
            if (lane < 4) { LI[(b * 4 + lane) * LP + p] = -INFINITY; LF[(b * 4 + lane) * LP + p] = 0.f; }
            continue;
        }
        const int pos = p - PADL;
        const float* src = pos < 16 ? a.meta + (size_t)pos * 1024 : a.x + ((size_t)b * SEQ + pos - 16) * 1024;
        f32x4 xv[4]; float ss = 0.f;
#pragma unroll
        for (int i = 0; i < 4; ++i) { xv[i] = *(const f32x4*)(src + 256 * i + 4 * lane); ss += (xv[i][0] * xv[i][0] + xv[i][1] * xv[i][1]) + (xv[i][2] * xv[i][2] + xv[i][3] * xv[i][3]); }
        ss = wave_sum(ss);
        const float rs = rsqrtf(ss * (1.0f / 1024.0f) + EPS);
        float g[8] = {0.f, 0.f, 0.f, 0.f, 0.f, 0.f, 0.f, 0.f};
#pragma unroll
        for (int i = 0; i < 4; ++i) { const f32x4 nw = *(const f32x4*)(a.norm_w + 256 * i + 4 * lane);
            f32x4 y; y[0] = xv[i][0] * rs * nw[0]; y[1] = xv[i][1] * rs * nw[1]; y[2] = xv[i][2] * rs * nw[2]; y[3] = xv[i][3] * rs * nw[3];
            *(u32x2*)(XN + (size_t)r * 1024 + 256 * i + 4 * lane) = (u32x2){cvt_pk_bf16(y[0], y[1]), cvt_pk_bf16(y[2], y[3])};
#pragma unroll
            for (int j = 0; j < 4; ++j) { const int k = 256 * i + 4 * lane + j; const f32x4 w0 = *(const LAS f32x4*)(wg + k * 8), w1 = *(const LAS f32x4*)(wg + k * 8 + 4);
                g[0] += y[j] * w0[0]; g[1] += y[j] * w0[1]; g[2] += y[j] * w0[2]; g[3] += y[j] * w0[3]; g[4] += y[j] * w1[0]; g[5] += y[j] * w1[1]; g[6] += y[j] * w1[2]; g[7] += y[j] * w1[3]; } }
#pragma unroll
        for (int j = 0; j < 8; ++j) g[j] = wave_sum(g[j]);
        if (lane < 4) {
            const float ip = (lane == 0 ? g[0] : lane == 1 ? g[1] : lane == 2 ? g[2] : g[3]) + a.b_i[lane];
            const float fp = (lane == 0 ? g[4] : lane == 1 ? g[5] : lane == 2 ? g[6] : g[7]) + a.b_f[lane];
            const float li = 15.0f * tanhf(ip * (1.0f / 15.0f));
            const float fc = 15.0f * tanhf(fp * (1.0f / 15.0f));
            const float lf = fminf(fc, 0.f) - log1pf(expf(-fabsf(fc)));
            LI[(b * 4 + lane) * LP + p] = li; LF[(b * 4 + lane) * LP + p] = lf;
        }
    }
}

__device__ void phase_prepass(LAS unsigned char* lds, const Args& a) {
    const int tid = threadIdx.x, wid = tid >> 6, lane = tid & 63, e16 = lane & 15, g = lane >> 4;
    LAS float* sm = (LAS float*)lds;
    const bf16_t* QB = (const bf16_t*)(a.ws + WS_R1); const bf16_t* KB = QB + (size_t)MP * 1024;
    const float* LI = (const float*)(a.ws + WS_LI); const float* LF = (const float*)(a.ws + WS_LF);
    float* EMT = (float*)(a.ws + WS_EMT); float* DECAY = (float*)(a.ws + WS_DECAY);
    bf16_t* QF = (bf16_t*)(a.ws + WS_R3); bf16_t* KWTF = QF + (size_t)NITEM * 16384; bf16_t* WF = KWTF + (size_t)NITEM * 16384;
    for (int item = blockIdx.x; item < NITEM; item += gridDim.x) {
        const int bh = item / NCH, c = item - bh * NCH, b = bh >> 2, h = bh & 3;
        const size_t row0 = (size_t)b * LP + 64 * c;
        if (wid == 0) {
            const float* lip = LI + bh * LP; const float* lfp = LF + bh * LP;
            float mprev = 0.f;
            for (int cc = 0; cc < c; ++cc) {
                const float lf = lfp[64 * cc + lane], li = lip[64 * cc + lane];
                const float bc = wave_scan_add(lf, lane);
                const float bl = __shfl(bc, 63);
                const float av = wave_max(bl - bc + li);
                mprev = fmaxf(bl + mprev, av);
            }
            const float lf = lfp[64 * c + lane], li = lip[64 * c + lane];
            const float bc = wave_scan_add(lf, lane);
            const float pm = wave_scan_max(li - bc, lane);
            const float mm = fmaxf(mprev, pm), mt = bc + mm, wi = __expf(mprev - mm);
            const float bl = __shfl(bc, 63), mnew = __shfl(mt, 63);
            const float kw = __expf(bl - bc + li - mnew);
            sm[lane] = bc; sm[64 + lane] = li; sm[128 + lane] = mt; sm[192 + lane] = wi; sm[256 + lane] = kw;
            EMT[bh * LP + 64 * c + lane] = __expf(-mt);
            if (lane == 63) DECAY[item] = wi;
        }
        __syncthreads();
        {
            const int tt = wid >> 1;
#pragma unroll
            for (int q = 0; q < 2; ++q) {
                const int st = (wid & 1) * 2 + q;
                f32x4 acc = {0.f, 0.f, 0.f, 0.f};
                if (st <= tt) {
                    const bf16_t* qp = QB + (row0 + 16 * tt + e16) * 1024 + h * 256 + 8 * g;
                    const bf16_t* kp = KB + (row0 + 16 * st + e16) * 1024 + h * 256 + 8 * g;
#pragma unroll
                    for (int kk = 0; kk < 8; ++kk) { const bf16x8 av = *(const bf16x8*)(qp + 32 * kk), bv = *(const bf16x8*)(kp + 32 * kk);
                        acc = __builtin_amdgcn_mfma_f32_16x16x32_bf16(av, bv, acc, 0, 0, 0); }
                }
                const int s = 16 * st + e16; const float bs = sm[s], lis = sm[64 + s];
#pragma unroll
                for (int r = 0; r < 4; ++r) { const int t = 16 * tt + 4 * g + r;
                    float v = 0.f;
                    if (s <= t) v = __expf(sm[t] - bs + lis - sm[128 + t]) * acc[r];
                    const int ks = s >> 5, lp = (t & 15) + 16 * ((s & 31) >> 3), j = s & 7;
                    WF[(size_t)item * 4096 + ((tt * 2 + ks) * 64 + lp) * 8 + j] = (bf16_t)(cvt_pk_bf16(v, 0.f) & 0xffffu); }
            }
        }
#pragma unroll
        for (int i = 0; i < 4; ++i) {
            const int slot = tid + 512 * i, lp = slot & 63, ft = slot >> 6, le = lp & 15, lg = lp >> 4;
            { const int kk = ft >> 2, tt = ft & 3, t = 16 * tt + le; const float wi = sm[192 + t];
              const bf16_t* qp = QB + (row0 + t) * 1024 + h * 256 + 32 * kk + 4 * lg;
              const u32x2 lo = *(const u32x2*)qp, hi = *(const u32x2*)(qp + 16);
              u32x4 w; w.x = cvt_pk_bf16(bf_lo(lo.x) * wi, bf_hi(lo.x) * wi); w.y = cvt_pk_bf16(bf_lo(lo.y) * wi, bf_hi(lo.y) * wi);
              w.z = cvt_pk_bf16(bf_lo(hi.x) * wi, bf_hi(hi.x) * wi); w.w = cvt_pk_bf16(bf_lo(hi.y) * wi, bf_hi(hi.y) * wi);
              *(u32x4*)(QF + (size_t)item * 16384 + (size_t)slot * 8) = w; }
            { const int dt = ft >> 1, ks = ft & 1, d = 16 * dt + le; float f[8];
#pragma unroll
              for (int j = 0; j < 8; ++j) { const int s = 32 * ks + 8 * lg + j; f[j] = sm[256 + s] * bf2f(KB[(row0 + s) * 1024 + h * 256 + d]); }
              u32x4 w; w.x = cvt_pk_bf16(f[0], f[1]); w.y = cvt_pk_bf16(f[2], f[3]); w.z = cvt_pk_bf16(f[4], f[5]); w.w = cvt_pk_bf16(f[6], f[7]);
              *(u32x4*)(KWTF + (size_t)item * 16384 + (size_t)slot * 8) = w; }
        }
        __syncthreads();
    }
}

__device__ void phase_scan(const Args& a) {
    const int tid = threadIdx.x, wid = tid >> 6, lane = tid & 63, e16 = lane & 15, g = lane >> 4;
    const bf16_t* VB = (const bf16_t*)(a.ws + WS_R2);
    const bf16_t* QF = (const bf16_t*)(a.ws + WS_R3); const bf16_t* KWTF = QF + (size_t)NITEM * 16384; const bf16_t* WF = KWTF + (size_t)NITEM * 16384;
    const float* DECAY = (const float*)(a.ws + WS_DECAY);
    bf16_t* HN = (bf16_t*)(a.ws + WS_R1); float* DEN = (float*)(a.ws + WS_DEN);
    const int nw = gridDim.x * 8;
    for (int job = wid * gridDim.x + blockIdx.x; job < 528; job += nw) {
        int bh, sl;
        if (job < 512) { const int jj = job & 255; bh = jj >> 4; sl = 2 * (jj & 15) + (job >> 8); } else { bh = job - 512; sl = 32; }
        const int b = bh >> 2, h = bh & 3;
        f32x4 C[16];
#pragma unroll
        for (int i = 0; i < 16; ++i) C[i] = (f32x4){0.f, 0.f, 0.f, 0.f};
        for (int c = 0; c < NCH; ++c) {
            const int item = bh * NCH + c; const size_t row0 = (size_t)b * LP + 64 * c;
            bf16x8 vf[2];
            if (sl < 32) {
                const bf16_t* vp = VB + (row0 + 8 * g) * 2048 + h * 512 + sl * 16 + e16;
#pragma unroll
                for (int ks = 0; ks < 2; ++ks)
#pragma unroll
                    for (int j = 0; j < 8; ++j) vf[ks][j] = (short)vp[(size_t)(32 * ks + j) * 2048];
            } else {
                const short one = (e16 == 0) ? (short)0x3F80 : (short)0;
#pragma unroll
                for (int ks = 0; ks < 2; ++ks)
#pragma unroll
                    for (int j = 0; j < 8; ++j) vf[ks][j] = one;
            }
            const bf16_t* qf = QF + (size_t)item * 16384 + lane * 8; const bf16_t* kf = KWTF + (size_t)item * 16384 + lane * 8; const bf16_t* wf = WF + (size_t)item * 4096 + lane * 8;
            f32x4 num[4];
#pragma unroll
            for (int i = 0; i < 4; ++i) num[i] = (f32x4){0.f, 0.f, 0.f, 0.f};
#pragma unroll
            for (int kk = 0; kk < 8; ++kk) {
                union { u32x4 u; bf16x8 v; } cf;
                cf.u.x = cvt_pk_bf16(C[2 * kk][0], C[2 * kk][1]); cf.u.y = cvt_pk_bf16(C[2 * kk][2], C[2 * kk][3]);
                cf.u.z = cvt_pk_bf16(C[2 * kk + 1][0], C[2 * kk + 1][1]); cf.u.w = cvt_pk_bf16(C[2 * kk + 1][2], C[2 * kk + 1][3]);
#pragma unroll
                for (int tt = 0; tt < 4; ++tt) { const bf16x8 q = *(const bf16x8*)(qf + (kk * 4 + tt) * 512);
                    num[tt] = __builtin_amdgcn_mfma_f32_16x16x32_bf16(q, cf.v, num[tt], 0, 0, 0); }
            }
#pragma unroll
            for (int tt = 0; tt < 4; ++tt)
#pragma unroll
                for (int ks = 0; ks < 2; ++ks) { const bf16x8 w = *(const bf16x8*)(wf + (tt * 2 + ks) * 512);
                    num[tt] = __builtin_amdgcn_mfma_f32_16x16x32_bf16(w, vf[ks], num[tt], 0, 0, 0); }
            const float decay = DECAY[item];
#pragma unroll
            for (int dt = 0; dt < 16; ++dt) { C[dt] = C[dt] * decay;
#pragma unroll
                for (int ks = 0; ks < 2; ++ks) { const bf16x8 k = *(const bf16x8*)(kf + (dt * 2 + ks) * 512);
                    C[dt] = __builtin_amdgcn_mfma_f32_16x16x32_bf16(k, vf[ks], C[dt], 0, 0, 0); } }
            if (c >= 1) {
                const size_t cr0 = (size_t)b * SEQ + 64 * (c - 1);
                if (sl < 32) {
#pragma unroll
                    for (int tt = 0; tt < 4; ++tt)
#pragma unroll
                        for (int r = 0; r < 4; ++r) HN[(cr0 + 16 * tt + 4 * g + r) * 2048 + h * 512 + sl * 16 + e16] = (bf16_t)(cvt_pk_bf16(num[tt][r], 0.f) & 0xffffu);
                } else if (e16 == 0) {
#pragma unroll
                    for (int tt = 0; tt < 4; ++tt)
#pragma unroll
                        for (int r = 0; r < 4; ++r) DEN[(cr0 + 16 * tt + 4 * g + r) * 4 + h] = num[tt][r];
                }
            }
        }
    }
}

__device__ void phase_stats(const Args& a) {
    const int wid = threadIdx.x >> 6, lane = threadIdx.x & 63;
    const bf16_t* HN = (const bf16_t*)(a.ws + WS_R1); const float* DEN = (const float*)(a.ws + WS_DEN); const float* EMT = (const float*)(a.ws + WS_EMT); float* SC = (float*)(a.ws + WS_SC);
    for (int i = blockIdx.x * 8 + wid; i < MC * 4; i += gridDim.x * 8) {
        const int cr = i >> 2, h = i & 3, b = cr >> 12, s = cr & 4095;
        const u32x4 hv = *(const u32x4*)(HN + (size_t)cr * 2048 + h * 512 + 8 * lane);
        const float dd = fmaxf(fabsf(DEN[i]), EMT[(b * 4 + h) * LP + 64 + s]);
        const float inv = 1.0f / dd;
        const float f[8] = {bf_lo(hv.x), bf_hi(hv.x), bf_lo(hv.y), bf_hi(hv.y), bf_lo(hv.z), bf_hi(hv.z), bf_lo(hv.w), bf_hi(hv.w)};
        float ss = 0.f;
#pragma unroll
        for (int j = 0; j < 8; ++j) { const float v = f[j] * inv; ss += v * v; }
        ss = wave_sum(ss);
        if (lane == 0) SC[i] = rsqrtf(ss * (1.0f / 512.0f) + EPS) * inv;
    }
}

__device__ void phase_conv(const Args& a) {
    const int wid = threadIdx.x >> 6, lane = threadIdx.x & 63;
    const bf16_t* U = (const bf16_t*)(a.ws + WS_R3); bf16_t* GS = (bf16_t*)(a.ws + WS_R2);
    for (int cr = blockIdx.x * 8 + wid; cr < MC; cr += gridDim.x * 8) {
        const int b = cr >> 12, s = cr & 4095; const size_t r = (size_t)b * LP + 64 + s;
#pragma unroll
        for (int it = 0; it < 4; ++it) {
            const int ch = 512 * it + 8 * lane;
            const u32x4 u0 = *(const u32x4*)(U + r * 2048 + ch), u1 = *(const u32x4*)(U + (r - 1) * 2048 + ch), u2 = *(const u32x4*)(U + (r - 2) * 2048 + ch);
            const u32x4 gs = *(const u32x4*)(GS + (size_t)cr * 2048 + ch);
            const unsigned u0w[4] = {u0.x, u0.y, u0.z, u0.w}, u1w[4] = {u1.x, u1.y, u1.z, u1.w}, u2w[4] = {u2.x, u2.y, u2.z, u2.w}, gw[4] = {gs.x, gs.y, gs.z, gs.w};
            unsigned ow[4];
#pragma unroll
            for (int q = 0; q < 4; ++q) {
                const int c0 = ch + 2 * q;
                const float w0a = a.conv_w[c0], w0b = a.conv_w[c0 + 1], w1a = a.conv_w[2048 + c0], w1b = a.conv_w[2048 + c0 + 1], w2a = a.conv_w[4096 + c0], w2b = a.conv_w[4096 + c0 + 1];
                const float ya = bf_lo(gw[q]) * (w0a * bf_lo(u2w[q]) + w1a * bf_lo(u1w[q]) + w2a * bf_lo(u0w[q]));
                const float yb = bf_hi(gw[q]) * (w0b * bf_hi(u2w[q]) + w1b * bf_hi(u1w[q]) + w2b * bf_hi(u0w[q]));
                ow[q] = cvt_pk_bf16(ya, yb);
            }
            *(u32x4*)(GS + (size_t)cr * 2048 + ch) = (u32x4){ow[0], ow[1], ow[2], ow[3]};
        }
    }
}

__device__ void phase_final(const Args& a) {
    const int wid = threadIdx.x >> 6, lane = threadIdx.x & 63;
    const float* SSQ = (const float*)(a.ws + WS_SSQ);
    for (int cr = blockIdx.x * 8 + wid; cr < MC; cr += gridDim.x * 8) {
        float ss = (lane < 16) ? SSQ[(size_t)cr * 16 + lane] : 0.f;
        ss = wave_sum(ss);
        const float rs = rsqrtf(ss * (1.0f / 1024.0f) + EPS);
#pragma unroll
        for (int i = 0; i < 4; ++i) { float* p = a.out + (size_t)cr * 1024 + 256 * i + 4 * lane; const f32x4 v = *(const f32x4*)p, w = *(const f32x4*)(a.fin_w + 256 * i + 4 * lane);
            *(f32x4*)p = (f32x4){v[0] * rs * w[0], v[1] * rs * w[1], v[2] * rs * w[2], v[3] * rs * w[3]}; }
    }
}

__global__ void __launch_bounds__(512, 2) fwd(Args a) {
    extern __shared__ __attribute__((aligned(16))) unsigned char lds_raw[];
    LAS unsigned char* lds = (LAS unsigned char*)lds_raw;
    cg::grid_group grid = cg::this_grid();
    const int lo = a.ph_lo, hi = a.ph_hi; const int G = gridDim.x, c = blockIdx.x;
#define IN(k) (lo <= (k) && (k) < hi)
#define SEAM(k) do { if (IN(k) && IN((k) + 1)) grid.sync(); } while (0)
    if (IN(0)) phase_prep(lds, a);
    SEAM(0);
    if (IN(1)) { SchedIn S{16, 0, G, c, (const char*)(a.ws + WS_XN), (const char*)(a.ws + WS_WINT)};
        EpiQKV E{(bf16_t*)(a.ws + WS_R1), (bf16_t*)(a.ws + WS_R1) + (size_t)MP * 1024, (bf16_t*)(a.ws + WS_R2)};
        pg8::gemm_phase(lds, 1024, S, E); }
    SEAM(1);
    if (IN(2)) phase_prepass(lds, a);
    SEAM(2);
    if (IN(3)) phase_scan(a);
    SEAM(3);
    if (IN(4)) phase_stats(a);
    SEAM(4);
    if (IN(5)) { SchedIn S{56, 16, G, c, (const char*)(a.ws + WS_XN), (const char*)(a.ws + WS_WINT)};
        EpiRest E{(bf16_t*)(a.ws + WS_R1), (const float*)(a.ws + WS_SC), a.mh_w, (bf16_t*)(a.ws + WS_R3), (bf16_t*)(a.ws + WS_R2), (bf16_t*)a.out};
        pg8::gemm_phase(lds, 1024, S, E); }
    SEAM(5);
    if (IN(6)) phase_conv(a);
    SEAM(6);
    if (IN(7)) { const int vc = (G == 256) ? ((c & 7) * 32 + (c >> 3)) : c;
        SchedMerge S{G, vc, (const char*)(a.ws + WS_R1), (const char*)(a.ws + WS_R2), (const char*)(a.ws + WS_WAT), (const char*)(a.ws + WS_WBT)};
        EpiMerge E{(const bf16_t*)a.out, (bf16_t*)(a.ws + WS_XN)};
        pg8::gemm_phase(lds, 2048, S, E); }
    SEAM(7);
    if (IN(8)) { const int vc = (G == 256) ? ((c & 7) * 32 + (c >> 3)) : c;
        SchedOut S{G, vc, (const char*)(a.ws + WS_XN), (const char*)(a.ws + WS_WOT)};
        EpiOut E{a.x, a.out, (float*)(a.ws + WS_SSQ)};
        pg8::gemm_phase(lds, 1024, S, E); }
    SEAM(8);
    if (IN(9)) phase_final(a);
#undef IN
#undef SEAM
}

constexpr int NPH = 10;
constexpr int LDS_BYTES = 131072;

extern "C" void kernel_launch(void* const* d_in, const int* in_sizes, int n_in, void* d_out, int out_size, void* d_ws, size_t ws_size, hipStream_t stream) {
    static int grid = 0;
    if (grid == 0) {
        int dev = 0, cus = 0, per_cu = 0;
        (void)hipGetDevice(&dev);
        (void)hipDeviceGetAttribute(&cus, hipDeviceAttributeMultiprocessorCount, dev);
        if (hipFuncSetAttribute((const void*)fwd, hipFuncAttributeMaxDynamicSharedMemorySize, LDS_BYTES) != hipSuccess) { fprintf(stderr, "hipFuncSetAttribute failed\n"); grid = -1; return; }
        (void)hipOccupancyMaxActiveBlocksPerMultiprocessor(&per_cu, (const void*)fwd, 512, LDS_BYTES);
        (void)hipGetLastError();
        if (per_cu < 1) per_cu = 1;
        grid = cus * 1;
        if (ws_size < WS_END) fprintf(stderr, "kernel_launch: workspace too small: %zu < %zu\n", ws_size, (size_t)WS_END);
    }
    if (grid < 0) return;
    Args a{};
    a.x = (const float*)d_in[0]; a.meta = (const float*)d_in[1]; a.norm_w = (const float*)d_in[2]; a.w_in = (const float*)d_in[3];
    a.b_i = (const float*)d_in[4]; a.b_f = (const float*)d_in[5]; a.mh_w = (const float*)d_in[6]; a.conv_w = (const float*)d_in[7];
    a.w_pa = (const float*)d_in[8]; a.w_pb = (const float*)d_in[9]; a.w_out = (const float*)d_in[10]; a.fin_w = (const float*)d_in[11];
    a.out = (float*)d_out; a.ws = (unsigned char*)d_ws;
#if SINGLE_LAUNCH
    a.ph_lo = 0; a.ph_hi = NPH;
    void* args[] = {&a};
    hipError_t e = hipLaunchCooperativeKernel((const void*)fwd, dim3(grid), dim3(512), args, LDS_BYTES, stream);
    if (e != hipSuccess) fprintf(stderr, "cooperative launch failed: %s (grid %d)\n", hipGetErrorString(e), grid);
#else
    for (int k = 0; k < NPH; ++k) { a.ph_lo = k; a.ph_hi = k + 1; hipLaunchKernelGGL(fwd, dim3(grid), dim3(512), LDS_BYTES, stream, a); }
#endif
}
```

```cpp
#include <hip/hip_runtime.h>
#include <hip/hip_cooperative_groups.h>
#include <cstdio>
namespace cg = cooperative_groups;

#ifndef SINGLE_LAUNCH
#define SINGLE_LAUNCH 1
#endif

#ifndef DBL_MASK
#define DBL_MASK 0
#endif
#ifndef PROBE_A
#define PROBE_A -1
#define PROBE_B -1
#endif

#define LAS __attribute__((address_space(3)))
typedef unsigned short bf16_t;
typedef short bf16x8 __attribute__((ext_vector_type(8)));
typedef float f32x4 __attribute__((ext_vector_type(4)));
typedef unsigned u32x4 __attribute__((ext_vector_type(4)));
typedef unsigned u32x2 __attribute__((ext_vector_type(2)));

constexpr int DM = 1024, NB = 4, SEQ = 4096, LP = 4160, PADL = 48, MP = NB * LP, MC = NB * SEQ, NCH = 65, NIN = 18440, NITEM = 16 * NCH;
constexpr int OFF_O = 4096, OFF_ZA = 6144, OFF_I = 8192, OFF_SH = 8200, OFF_SB = 10248, OFF_SC = 12296, OFF_ZS = 14344, OFF_GA = 16392, OFF_GB = 17416;
constexpr float EPS = 1e-6f;

constexpr size_t SZ_XN = (size_t)MP * 1024 * 2, SZ_WINT = (size_t)18432 * 1024 * 2, SZ_W2 = (size_t)1024 * 2048 * 2, SZ_WO = (size_t)1024 * 1024 * 2;
constexpr size_t SZ_G = (size_t)16 * LP * 4, SZ_C4 = (size_t)MC * 4 * 4;
constexpr size_t WS_XN = 0, WS_WINT = WS_XN + SZ_XN, WS_WAT = WS_WINT + SZ_WINT, WS_WBT = WS_WAT + SZ_W2, WS_WOT = WS_WBT + SZ_W2,
                 WS_LI = WS_WOT + SZ_WO, WS_LF = WS_LI + SZ_G, WS_EMT = WS_LF + SZ_G, WS_DEN = WS_EMT + SZ_G, WS_SC = WS_DEN + SZ_C4,
                 WS_DECAY = WS_SC + SZ_C4, WS_SSQ = WS_DECAY + 4352, WS_KWS = WS_SSQ + (size_t)MC * 16 * 4, WS_RW = WS_KWS + (size_t)NITEM * 256 * 4,
                 WS_BAR = WS_RW + (size_t)NITEM * 64 * 4, WS_SUM = WS_BAR + 65536, WS_R1 = WS_SUM + 8448,
                 WS_R2 = WS_R1 + (size_t)MP * 2048 * 2, WS_R3 = WS_R2 + (size_t)MP * 2048 * 2,
                 SZ_QF = (size_t)NITEM * 16384 * 2, SZ_WF = (size_t)NITEM * 4096 * 2, WS_END = WS_R3 + 2 * SZ_QF + SZ_WF;
static_assert(WS_END <= (size_t)4 * 1024 * 18440 * 4, "workspace budget");
static_assert(WS_R1 % 256 == 0 && WS_R3 % 256 == 0, "align");

constexpr int LDS_BAR_OFF = 131072 + 2 * 4608 + 5 * 1024, LDS_DEC_OFF = LDS_BAR_OFF + 16, LDS_BYTES = LDS_DEC_OFF + 272;
struct Args {
    const float* x; const float* meta; const float* norm_w; const float* w_in; const float* b_i; const float* b_f; const float* mh_w;
    const float* conv_w; const float* w_pa; const float* w_pb; const float* w_out; const float* fin_w;
    float* out; unsigned char* ws; int ph_lo, ph_hi;
};

__device__ __forceinline__ unsigned cvt_pk_bf16(float lo, float hi) { unsigned r; asm volatile("v_cvt_pk_bf16_f32 %0, %1, %2" : "=v"(r) : "v"(lo), "v"(hi)); return r; }
__device__ __forceinline__ float bf_lo(unsigned w) { return __uint_as_float(w << 16); }
__device__ __forceinline__ float bf_hi(unsigned w) { return __uint_as_float(w & 0xffff0000u); }
__device__ __forceinline__ float bf2f(bf16_t b) { return __uint_as_float(((unsigned)b) << 16); }
__device__ __forceinline__ float ex2(float x) { return __builtin_amdgcn_exp2f(x); }
__device__ __forceinline__ float en(float x) { return ex2(fminf(-1.4426950409f * x, 100.f)); }
__device__ __forceinline__ float enu(float x) { return ex2(-1.4426950409f * x); }
__device__ __forceinline__ float sigm(float x) { return __builtin_amdgcn_rcpf(1.0f + enu(x)); }
#define DPP_ROR(n) (0x120 | (n))
#define DPP_SHR(n) (0x110 | (n))
template <int CTRL> __device__ __forceinline__ float dpp_f(float oldv, float v) {
    return __int_as_float(__builtin_amdgcn_update_dpp(__float_as_int(oldv), __float_as_int(v), CTRL, 0xf, 0xf, false)); }
__device__ __forceinline__ float rl_f(float v, int l) { return __int_as_float(__builtin_amdgcn_readlane(__float_as_int(v), l)); }
__device__ __forceinline__ float row_sum16(float v) {
    v += dpp_f<DPP_ROR(8)>(v, v); v += dpp_f<DPP_ROR(4)>(v, v); v += dpp_f<DPP_ROR(2)>(v, v); v += dpp_f<DPP_ROR(1)>(v, v); return v; }
__device__ __forceinline__ float row_max16(float v) {
    v = fmaxf(v, dpp_f<DPP_ROR(8)>(v, v)); v = fmaxf(v, dpp_f<DPP_ROR(4)>(v, v)); v = fmaxf(v, dpp_f<DPP_ROR(2)>(v, v)); v = fmaxf(v, dpp_f<DPP_ROR(1)>(v, v)); return v; }
__device__ __forceinline__ float wave_sum(float v) { v = row_sum16(v); return (rl_f(v, 0) + rl_f(v, 16)) + (rl_f(v, 32) + rl_f(v, 48)); }
__device__ __forceinline__ float wave_max(float v) { v = row_max16(v); return fmaxf(fmaxf(rl_f(v, 0), rl_f(v, 16)), fmaxf(rl_f(v, 32), rl_f(v, 48))); }
__device__ __forceinline__ float wave_scan_add(float v, int lane) {
    v += dpp_f<DPP_SHR(1)>(0.f, v); v += dpp_f<DPP_SHR(2)>(0.f, v); v += dpp_f<DPP_SHR(4)>(0.f, v); v += dpp_f<DPP_SHR(8)>(0.f, v);
    const float t0 = rl_f(v, 15), t1 = rl_f(v, 31), t2 = rl_f(v, 47);
    const float add = (lane >= 48) ? (t0 + t1) + t2 : (lane >= 32) ? t0 + t1 : (lane >= 16) ? t0 : 0.f;
    return v + add; }
__device__ __forceinline__ float wave_scan_max(float v, int lane) {
    const float ninf = -INFINITY;
    v = fmaxf(v, dpp_f<DPP_SHR(1)>(ninf, v)); v = fmaxf(v, dpp_f<DPP_SHR(2)>(ninf, v)); v = fmaxf(v, dpp_f<DPP_SHR(4)>(ninf, v)); v = fmaxf(v, dpp_f<DPP_SHR(8)>(ninf, v));
    const float t0 = rl_f(v, 15), t1 = rl_f(v, 31), t2 = rl_f(v, 47);
    const float mx = (lane >= 48) ? fmaxf(fmaxf(t0, t1), t2) : (lane >= 32) ? fmaxf(t0, t1) : (lane >= 16) ? t0 : ninf;
    return fmaxf(v, mx); }

#define XB_TMO      128
#define XB_XCNT(j)  (256  + 64 * (j))
#define XB_XSUB(j)  (1280 + 64 * (j))
#define XB_XGEN(j)  (2304 + 64 * (j))
#define XB_TOP      3328
#define XB_TOPGEN   3392
#define XCD_BAR_WORDS 3456
#define XB_SPIN_CAP (1u << 20)
__device__ __forceinline__ unsigned xb_ld(unsigned* p)              { return __hip_atomic_load(p, __ATOMIC_RELAXED, __HIP_MEMORY_SCOPE_AGENT); }
__device__ __forceinline__ unsigned xb_add(unsigned* p, unsigned v) { return __hip_atomic_fetch_add(p, v, __ATOMIC_RELAXED, __HIP_MEMORY_SCOPE_AGENT); }
__device__ __forceinline__ unsigned xb_xcc_id() { return (unsigned)__builtin_amdgcn_s_getreg((3 << 11) | 20) & 0xFu; }
#define XB_SPIN(cond, bar) do { unsigned _sp = 0; while (cond) { __builtin_amdgcn_s_sleep(1); \
    if ((++_sp & 255u) == 0u) { if (xb_ld(&(bar)[XB_TMO])) break; if (_sp > XB_SPIN_CAP) { atomicAdd(&(bar)[XB_TMO], 1u); break; } } } } while (0)
struct XcdBarrier { unsigned* bar; unsigned x; volatile LAS unsigned* st; };
__device__ __forceinline__ XcdBarrier xcd_barrier_post(unsigned* bar, volatile LAS unsigned* st) {
    XcdBarrier b; b.bar = bar; b.x = xb_xcc_id(); b.st = st;
    if (threadIdx.x == 0) (void)xb_add(&bar[XB_XCNT(b.x)], 1u);
    return b;
}
__device__ __forceinline__ void xcd_barrier_complete(unsigned* bar, unsigned x, unsigned& nloc, unsigned& nx) {
    const unsigned G = gridDim.x * gridDim.y * gridDim.z;
    unsigned sum, cnt, mine, sp = 0u;
    for (;;) {
        sum = 0u; cnt = 0u; mine = 0u;
#pragma unroll
        for (unsigned j = 0; j < 16; ++j) { const unsigned c = xb_ld(&bar[XB_XCNT(j)]); sum += c; cnt += (c > 0u) ? 1u : 0u; mine = (j == x) ? c : mine; }
        if (sum == G) break;
        __builtin_amdgcn_s_sleep(1);
        if ((++sp & 255u) == 0u) { if (xb_ld(&bar[XB_TMO])) break; if (sp > XB_SPIN_CAP) { atomicAdd(&bar[XB_TMO], 1u); break; } }
    }
    nloc = mine > 0u ? mine : 1u; nx = cnt > 0u ? cnt : 1u;
}
__device__ __forceinline__ void xcd_barrier(const XcdBarrier& b) {
    asm volatile("s_waitcnt vmcnt(0)" ::: "memory");
    __syncthreads();
    if (threadIdx.x == 0) {
        unsigned* bar = b.bar;
        __builtin_amdgcn_s_waitcnt(0);
        unsigned nloc = b.st[0], nx = b.st[1];
        if (nloc == 0u) { xcd_barrier_complete(bar, b.x, nloc, nx); b.st[0] = nloc; b.st[1] = nx; }
        const unsigned old = xb_add(&bar[XB_XSUB(b.x)], 1u);
        const unsigned gen = old / nloc;
        if (old + 1u == (gen + 1u) * nloc) {
            __builtin_amdgcn_fence(__ATOMIC_RELEASE, "agent");
            asm volatile("s_waitcnt vmcnt(0)" ::: "memory");
            const unsigned og = xb_add(&bar[XB_TOP], 1u);
            const unsigned tg = og / nx;
            if (og + 1u == (tg + 1u) * nx) xb_add(&bar[XB_TOPGEN], 1u);
            else XB_SPIN(xb_ld(&bar[XB_TOPGEN]) == tg, bar);
            __builtin_amdgcn_fence(__ATOMIC_ACQUIRE, "agent");
            xb_add(&bar[XB_XGEN(b.x)], 1u);
            asm volatile("s_waitcnt vmcnt(0)" ::: "memory");
        } else {
            XB_SPIN(xb_ld(&bar[XB_XGEN(b.x)]) == gen, bar);
            __builtin_amdgcn_fence(__ATOMIC_ACQUIRE, "agent");
            asm volatile("s_waitcnt vmcnt(0)" ::: "memory");
        }
    }
    __syncthreads();
}

namespace pg8 {
constexpr int BM = 256, BK = 64, HALF = 128, HTB = HALF * BK * 2, STAGE_BYTES = 8 * HTB, NXCD = 8, WGM = 8;
__device__ __forceinline__ int lds_byte(int r, int c) { const int st = (r >> 4) * 2 + (c >> 5), rr = r & 15, cc = c & 31, ob = rr * 64 + cc * 2; return st * 1024 + (ob ^ (((ob >> 9) & 1) << 5)); }
__device__ __forceinline__ void stage_rc(int b, int& R, int& C) { const int st = b / 1024, sb = b % 1024, swz = sb ^ (((sb >> 9) & 1) << 5); R = (st >> 1) * 16 + swz / 64; C = (st & 1) * 32 + (swz % 64) / 2; }
__device__ __forceinline__ int perm32(int rho) { const int n = rho >> 4, i = rho & 15; return 8 * (i >> 2) + 4 * n + (i & 3); }
struct Unit { int pm, pn, seg; };

template <class Epi, class Sched>
__device__ __forceinline__ void gemm_phase(LAS unsigned char* lds, const int K, const Sched& S, const Epi& E) {
    const int tid = threadIdx.x, wid = __builtin_amdgcn_readfirstlane(tid >> 6), lane = tid & 63, wr = wid >> 2, wc = wid & 3, fr = lane & 15, fq = lane >> 4;
    const int nt = K / BK;
    unsigned voffA[2], voffB[2];
#pragma unroll
    for (int i = 0; i < 2; ++i) { int R, C; stage_rc(tid * 16 + i * 8192, R, C); const int Rb = Epi::PERM ? ((R & ~31) + perm32(R & 31)) : R;
        voffA[i] = (unsigned)(R * K + C) * 2u; voffB[i] = (unsigned)(Rb * K + C) * 2u; }
    const size_t kstep = (size_t)(BK * 2);
    const size_t hstep = (size_t)HALF * K * 2;
    const unsigned ldsw = (unsigned)wid * 1024u;
    const int aoff = lds_byte(wr * 64 + fr, fq * 8), boff = lds_byte(wc * 32 + fr, fq * 8);
#define PG8_SA(b, h) (((b) * 2 + (h)) * HTB)
#define PG8_SB(b, h) ((4 + (b) * 2 + (h)) * HTB)
#define PG8_STAGE(bufoff, gbase, voff) do { _Pragma("unroll") for (int _i = 0; _i < 2; ++_i) \
        __builtin_amdgcn_global_load_lds((const unsigned*)((const char*)(gbase) + (voff)[_i]), (LAS unsigned*)(lds + (bufoff) + ldsw + _i * 8192), 16, 0, 0); } while (0)
#define PG8_LDA(dst, b, h) do { _Pragma("unroll") for (int m = 0; m < 4; ++m) _Pragma("unroll") for (int k = 0; k < 2; ++k) dst[m][k] = *(const LAS bf16x8*)(lds + PG8_SA(b, h) + aoff + m * 2048 + k * 1024); } while (0)
#define PG8_LDB(dst, b, h) do { _Pragma("unroll") for (int n = 0; n < 2; ++n) _Pragma("unroll") for (int k = 0; k < 2; ++k) dst[n][k] = *(const LAS bf16x8*)(lds + PG8_SB(b, h) + boff + n * 2048 + k * 1024); } while (0)
#define PG8_MMA(ai, bj, At, Bt) do { __builtin_amdgcn_s_setprio(1); _Pragma("unroll") for (int m = 0; m < 4; ++m) _Pragma("unroll") for (int n = 0; n < 2; ++n) _Pragma("unroll") for (int k = 0; k < 2; ++k) \
        acc[ai][bj][m][n] = __builtin_amdgcn_mfma_f32_16x16x32_bf16(Bt[n][k], At[m][k], acc[ai][bj][m][n], 0, 0, 0); __builtin_amdgcn_s_setprio(0); } while (0)
#define PG8_WAIT_V(n) asm volatile("s_waitcnt vmcnt(" #n ")" ::: "memory")
#define PG8_WAIT_L(n) asm volatile("s_waitcnt lgkmcnt(" #n ")" ::: "memory")
#define PG8_BAR __builtin_amdgcn_s_barrier()
#define PG8_SCHED __builtin_amdgcn_sched_barrier(0)
    Unit cur, nxt; int ui = 0;
    if (!S.next(0, cur)) return;
    f32x4 acc[2][2][4][2];
#pragma unroll
    for (int a = 0; a < 2; ++a)
#pragma unroll
        for (int b = 0; b < 2; ++b)
#pragma unroll
            for (int m = 0; m < 4; ++m)
#pragma unroll
                for (int n = 0; n < 2; ++n) acc[a][b][m][n] = (f32x4){0.f, 0.f, 0.f, 0.f};
    bf16x8 At[4][2], B0[2][2], B1[2][2];
    const char* cA = S.abase(cur); const char* cB = S.bbase(cur);
    PG8_STAGE(PG8_SB(0, 0), cB, voffB); PG8_STAGE(PG8_SA(0, 0), cA, voffA); PG8_STAGE(PG8_SB(0, 1), cB + hstep, voffB); PG8_STAGE(PG8_SA(0, 1), cA + hstep, voffA);
    if (wr == 1) PG8_BAR;
    PG8_WAIT_V(4); PG8_BAR;
    PG8_STAGE(PG8_SB(1, 0), cB + kstep, voffB); PG8_STAGE(PG8_SA(1, 0), cA + kstep, voffA); PG8_STAGE(PG8_SB(1, 1), cB + hstep + kstep, voffB);
    PG8_WAIT_V(6); PG8_BAR;
    for (;;) {
        const bool has_next = S.next(ui + 1, nxt);
        const char* nA = has_next ? S.abase(nxt) : cA; const char* nB = has_next ? S.bbase(nxt) : cB;
        for (int t = 0; t < nt; t += 2) {
            const bool last = (t == nt - 2);
            const char* a1 = cA + (size_t)(t + 1) * kstep;
            const char* a2 = last ? nA : cA + (size_t)(t + 2) * kstep; const char* b2 = last ? nB : cB + (size_t)(t + 2) * kstep;
            const char* a3 = a2 + kstep; const char* b3 = b2 + kstep;
            PG8_LDB(B0, 0, 0); PG8_SCHED; PG8_LDA(At, 0, 0); PG8_STAGE(PG8_SA(1, 1), a1 + hstep, voffA);
            PG8_WAIT_L(8); PG8_BAR; PG8_WAIT_L(0); PG8_MMA(0, 0, At, B0); PG8_BAR; PG8_SCHED;
            PG8_LDB(B1, 0, 1); PG8_STAGE(PG8_SB(0, 0), b2, voffB);
            PG8_BAR; PG8_WAIT_L(0); PG8_MMA(0, 1, At, B1); PG8_BAR;
            PG8_LDA(At, 0, 1); PG8_STAGE(PG8_SA(0, 0), a2, voffA);
            PG8_BAR; PG8_WAIT_L(0); PG8_MMA(1, 0, At, B0); PG8_BAR; PG8_SCHED;
            PG8_STAGE(PG8_SB(0, 1), b2 + hstep, voffB);
            PG8_WAIT_V(6); PG8_BAR; PG8_MMA(1, 1, At, B1); PG8_BAR;
            PG8_LDB(B0, 1, 0); PG8_SCHED; PG8_LDA(At, 1, 0); PG8_STAGE(PG8_SA(0, 1), a2 + hstep, voffA);
            PG8_WAIT_L(8); PG8_BAR; PG8_WAIT_L(0); PG8_MMA(0, 0, At, B0); PG8_BAR; PG8_SCHED;
            PG8_LDB(B1, 1, 1); PG8_STAGE(PG8_SB(1, 0), b3, voffB);
            PG8_BAR; PG8_WAIT_L(0); PG8_MMA(0, 1, At, B1); PG8_BAR;
            PG8_LDA(At, 1, 1); PG8_STAGE(PG8_SA(1, 0), a3, voffA);
            PG8_BAR; PG8_WAIT_L(0); PG8_MMA(1, 0, At, B0); PG8_BAR; PG8_SCHED;
            PG8_STAGE(PG8_SB(1, 1), b3 + hstep, voffB);
            PG8_WAIT_V(6); PG8_BAR; PG8_MMA(1, 1, At, B1); PG8_BAR;
        }
        if constexpr (!Epi::AFTER_DRAIN) E(acc, cur, wr, wc, fr, fq);
        if (!has_next) break;
        if (E.zero_after(cur)) {
#pragma unroll
            for (int a = 0; a < 2; ++a)
#pragma unroll
                for (int b = 0; b < 2; ++b)
#pragma unroll
                    for (int m = 0; m < 4; ++m)
#pragma unroll
                        for (int n = 0; n < 2; ++n) acc[a][b][m][n] = (f32x4){0.f, 0.f, 0.f, 0.f};
        }
        cur = nxt; cA = nA; cB = nB; ++ui;
    }
    PG8_WAIT_V(0);
    if (wr == 0) PG8_BAR;
    PG8_BAR;
    if constexpr (Epi::AFTER_DRAIN) E(acc, cur, wr, wc, fr, fq);
#undef PG8_SA
#undef PG8_SB
#undef PG8_STAGE
#undef PG8_LDA
#undef PG8_LDB
#undef PG8_MMA
#undef PG8_WAIT_V
#undef PG8_WAIT_L
#undef PG8_BAR
#undef PG8_SCHED
}
}
using pg8::Unit;

struct SchedIn {
    int nN, pnoff, G, c; const char* A; const char* B;
    __device__ __forceinline__ bool next(int i, Unit& u) const {
        const int nM = 65, nwg = nM * nN; const long L = (long)i * G + c; if (L >= nwg) return false;
        int wgid = (int)L; { const int q = nwg / 8, r = nwg % 8, xcd = wgid % 8, off = wgid / 8; wgid = (xcd < r ? xcd * (q + 1) : r * (q + 1) + (xcd - r) * q) + off; }
        const int nig = 8 * nN, gid = wgid / nig, fm = gid * 8, gsz = (nM - fm) < 8 ? (nM - fm) : 8;
        u.pm = fm + ((wgid % nig) % gsz); u.pn = pnoff + (wgid % nig) / gsz; u.seg = 0; return true;
    }
    __device__ __forceinline__ const char* abase(const Unit& u) const { return A + (size_t)u.pm * (256 * 1024 * 2); }
    __device__ __forceinline__ const char* bbase(const Unit& u) const { return B + (size_t)u.pn * (256 * 1024 * 2); }
};
struct SchedMerge {
    int G, c; const char* A0; const char* A1; const char* B0; const char* B1;
    __device__ __forceinline__ bool next(int i, Unit& u) const {
        const int tile = (i >> 1) * G + c; if (tile >= 256) return false;
        u.pm = tile >> 2; u.pn = tile & 3; u.seg = i & 1; return true;
    }
    __device__ __forceinline__ const char* abase(const Unit& u) const { return (u.seg ? A1 : A0) + (size_t)u.pm * (256 * 2048 * 2); }
    __device__ __forceinline__ const char* bbase(const Unit& u) const { return (u.seg ? B1 : B0) + (size_t)u.pn * (256 * 2048 * 2); }
};
struct SchedOut {
    int G, c; const char* A; const char* B;
    __device__ __forceinline__ bool next(int i, Unit& u) const {
        const int tile = i * G + c; if (tile >= 256) return false;
        u.pm = tile >> 2; u.pn = tile & 3; u.seg = 0; return true;
    }
    __device__ __forceinline__ const char* abase(const Unit& u) const { return A + (size_t)u.pm * (256 * 1024 * 2); }
    __device__ __forceinline__ const char* bbase(const Unit& u) const { return B + (size_t)u.pn * (256 * 1024 * 2); }
};

struct EpiQKV {
    static constexpr bool AFTER_DRAIN = false;
    static constexpr bool PERM = true;
    bf16_t* QB; bf16_t* KB; bf16_t* VB;
    __device__ __forceinline__ bool zero_after(const Unit&) const { return true; }
    __device__ __forceinline__ void operator()(f32x4 (&acc)[2][2][4][2], const Unit& u, int wr, int wc, int fr, int fq) const {
        bf16_t* base; int ldc, colt; float sc = 1.f;
        if (u.pn < 4) { base = QB; ldc = 1024; colt = u.pn * 256; sc = 0.0625f; }
        else if (u.pn < 8) { base = KB; ldc = 1024; colt = (u.pn - 4) * 256; }
        else { base = VB; ldc = 2048; colt = (u.pn - 8) * 256; }
        const int row0 = u.pm * 256 + wr * 64 + fr, col0 = colt + wc * 32 + 8 * fq;
#pragma unroll
        for (int ai = 0; ai < 2; ++ai)
#pragma unroll
            for (int m = 0; m < 4; ++m) { bf16_t* rowp = base + (size_t)(row0 + ai * 128 + m * 16) * ldc + col0;
#pragma unroll
                for (int bj = 0; bj < 2; ++bj) { const f32x4 v0 = acc[ai][bj][m][0] * sc, v1 = acc[ai][bj][m][1] * sc;
                    u32x4 w; w.x = cvt_pk_bf16(v0[0], v0[1]); w.y = cvt_pk_bf16(v0[2], v0[3]); w.z = cvt_pk_bf16(v1[0], v1[1]); w.w = cvt_pk_bf16(v1[2], v1[3]);
                    *(u32x4*)(rowp + bj * 128) = w; } }
    }
};
struct EpiRest {
    static constexpr bool AFTER_DRAIN = false;
    static constexpr bool PERM = true;
    bf16_t* HN; const float* SC; const float* mhw; const float* convw; bf16_t* UB; bf16_t* UF; bf16_t* GSB; bf16_t* GS; bf16_t* GG;
    __device__ __forceinline__ bool zero_after(const Unit&) const { return true; }
    __device__ __forceinline__ void operator()(f32x4 (&acc)[2][2][4][2], const Unit& u, int wr, int wc, int fr, int fq) const {
        const int row0 = u.pm * 256 + wr * 64 + fr; const int cw = wc * 32 + 8 * fq;
        if (u.pn >= 64) {
            const int col0 = (u.pn - 64) * 256 + cw;
#pragma unroll
            for (int ai = 0; ai < 2; ++ai)
#pragma unroll
                for (int m = 0; m < 4; ++m) { const int r = row0 + ai * 128 + m * 16, b = r / LP, p = r - b * LP; if (p < 64) continue;
                    bf16_t* rowp = GG + (size_t)(b * SEQ + p - 64) * 2048 + col0;
#pragma unroll
                    for (int bj = 0; bj < 2; ++bj) { const f32x4 v0 = acc[ai][bj][m][0], v1 = acc[ai][bj][m][1];
                        u32x4 w; w.x = cvt_pk_bf16(v0[0], v0[1]); w.y = cvt_pk_bf16(v0[2], v0[3]); w.z = cvt_pk_bf16(v1[0], v1[1]); w.w = cvt_pk_bf16(v1[2], v1[3]);
                        *(u32x4*)(rowp + bj * 128) = w; } }
            return;
        }
        if (u.pn >= 32) {
            const int chl = 64 * (u.pn - 32) + 16 * wc + 4 * fq;
            const f32x4 cw0 = *(const f32x4*)(convw + chl), cw1 = *(const f32x4*)(convw + 2048 + chl), cw2 = *(const f32x4*)(convw + 4096 + chl);
            asm volatile("" :: "v"(cw0), "v"(cw1), "v"(cw2));
            f32x4 uu[2][4];
#pragma unroll
            for (int ai = 0; ai < 2; ++ai)
#pragma unroll
                for (int m = 0; m < 4; ++m) uu[ai][m] = acc[ai][0][m][0] * acc[ai][0][m][1];
#pragma unroll
            for (int ai = 0; ai < 2; ++ai)
#pragma unroll
                for (int m = 0; m < 4; ++m) {
                    const int r = row0 + ai * 128 + m * 16, b = r / LP, p = r - b * LP; const size_t cr = (size_t)(b * SEQ + p - 64);
                    const f32x4 cur = uu[ai][m], sb = acc[ai][1][m][0], zs = acc[ai][1][m][1];
                    f32x4 u1, u2, gs;
#pragma unroll
                    for (int jj = 0; jj < 4; ++jj) {
                        const float s1 = dpp_f<DPP_SHR(1)>(0.f, cur[jj]), s2 = dpp_f<DPP_SHR(2)>(0.f, cur[jj]);
                        float r1 = 0.f, r2 = 0.f;
                        if (m > 0) { const float pv = uu[ai][m > 0 ? m - 1 : 0][jj]; r1 = dpp_f<DPP_ROR(1)>(pv, pv); r2 = dpp_f<DPP_ROR(2)>(pv, pv); }
                        u1[jj] = (fr >= 1) ? s1 : r1; u2[jj] = (fr >= 2) ? s2 : r2;
                        gs[jj] = zs[jj] * sigm(zs[jj]) * sb[jj];
                    }
                    const size_t grp = (size_t)(r >> 6);
                    if (m == 0 && fr < 2) {
                        *(u32x2*)(UF + (grp * 2 + fr) * 2048 + chl) = (u32x2){cvt_pk_bf16(cur[0], cur[1]), cvt_pk_bf16(cur[2], cur[3])};
                        *(u32x2*)(GSB + (grp * 2 + fr) * 2048 + chl) = (u32x2){cvt_pk_bf16(gs[0], gs[1]), cvt_pk_bf16(gs[2], gs[3])};
                    } else if (p >= 64) {
                        f32x4 y;
#pragma unroll
                        for (int jj = 0; jj < 4; ++jj) y[jj] = gs[jj] * (cw0[jj] * u2[jj] + cw1[jj] * u1[jj] + cw2[jj] * cur[jj]);
                        *(u32x2*)(GS + cr * 2048 + chl) = (u32x2){cvt_pk_bf16(y[0], y[1]), cvt_pk_bf16(y[2], y[3])};
                    }
                    if (m == 3 && fr >= 14) *(u32x2*)(UB + (grp * 2 + fr - 14) * 2048 + chl) = (u32x2){cvt_pk_bf16(cur[0], cur[1]), cvt_pk_bf16(cur[2], cur[3])};
                }
            return;
        }
        const int ch0 = (u.pn - 16) * 128 + cw;
        float mw[8];
#pragma unroll
        for (int j = 0; j < 8; ++j) mw[j] = mhw[ch0 + j];
        u32x4 hnv[2][4]; float scv[2][4];
#pragma unroll
        for (int ai = 0; ai < 2; ++ai)
#pragma unroll
            for (int m = 0; m < 4; ++m) { const int r = row0 + ai * 128 + m * 16, b = r / LP, p = r - b * LP; const size_t cr = (p >= 64) ? (size_t)(b * SEQ + p - 64) : 0;
                hnv[ai][m] = *(const u32x4*)(HN + cr * 2048 + ch0); scv[ai][m] = SC[cr * 4 + (ch0 >> 9)]; }
#pragma unroll
        for (int ai = 0; ai < 2; ++ai)
#pragma unroll
            for (int m = 0; m < 4; ++m) {
                const int r = row0 + ai * 128 + m * 16, b = r / LP, p = r - b * LP; const size_t cr = (size_t)(b * SEQ + p - 64);
                float v[8];
                const u32x4 hn = hnv[ai][m]; const float sc = scv[ai][m];
                const float hv[8] = {bf_lo(hn.x), bf_hi(hn.x), bf_lo(hn.y), bf_hi(hn.y), bf_lo(hn.z), bf_hi(hn.z), bf_lo(hn.w), bf_hi(hn.w)};
#pragma unroll
                for (int j = 0; j < 8; ++j) { const float o = acc[ai][0][m][j >> 2][j & 3], z = acc[ai][1][m][j >> 2][j & 3]; v[j] = z * __builtin_amdgcn_rcpf((1.0f + enu(z)) * (1.0f + en(o))) * (hv[j] * sc * mw[j]); }
                u32x4 w; w.x = cvt_pk_bf16(v[0], v[1]); w.y = cvt_pk_bf16(v[2], v[3]); w.z = cvt_pk_bf16(v[4], v[5]); w.w = cvt_pk_bf16(v[6], v[7]);
                if (p >= 64) *(u32x4*)(HN + cr * 2048 + ch0) = w;
            }
    }
};
struct EpiMerge {
    static constexpr bool AFTER_DRAIN = false;
    static constexpr bool PERM = true;
    const bf16_t* GG; bf16_t* MG;
    __device__ __forceinline__ bool zero_after(const Unit& u) const { return u.seg == 1; }
    __device__ __forceinline__ void operator()(f32x4 (&acc)[2][2][4][2], const Unit& u, int wr, int wc, int fr, int fq) const {
        const int row0 = u.pm * 256 + wr * 64 + fr, col0 = u.pn * 256 + wc * 32 + 8 * fq;
#pragma unroll
        for (int ai = 0; ai < 2; ++ai) {
            u32x4 gaq[4][2], gbq[4][2];
#pragma unroll
            for (int m = 0; m < 4; ++m) { const size_t cr = (size_t)(row0 + ai * 128 + m * 16);
#pragma unroll
                for (int bj = 0; bj < 2; ++bj) { gbq[m][bj] = *(const u32x4*)(GG + cr * 2048 + 1024 + col0 + bj * 128);
                    gaq[m][bj] = (u.seg == 0) ? *(const u32x4*)(GG + cr * 2048 + col0 + bj * 128) : gbq[m][bj]; } }
#pragma unroll
            for (int m = 0; m < 4; ++m) { const size_t cr = (size_t)(row0 + ai * 128 + m * 16);
#pragma unroll
                for (int bj = 0; bj < 2; ++bj) {
                    const u32x4 ga = gaq[m][bj], gb = gbq[m][bj];
                    const float gav[8] = {bf_lo(ga.x), bf_hi(ga.x), bf_lo(ga.y), bf_hi(ga.y), bf_lo(ga.z), bf_hi(ga.z), bf_lo(ga.w), bf_hi(ga.w)};
                    const float gbv[8] = {bf_lo(gb.x), bf_hi(gb.x), bf_lo(gb.y), bf_hi(gb.y), bf_lo(gb.z), bf_hi(gb.z), bf_lo(gb.w), bf_hi(gb.w)};
                    if (u.seg == 0) {
#pragma unroll
                        for (int j = 0; j < 8; ++j) acc[ai][bj][m][j >> 2][j & 3] *= (1.0f + en(gbv[j])) * __builtin_amdgcn_rcpf(1.0f + en(gav[j]));
                    } else {
                        float v[8];
#pragma unroll
                        for (int j = 0; j < 8; ++j) v[j] = acc[ai][bj][m][j >> 2][j & 3] * __builtin_amdgcn_rcpf(1.0f + en(gbv[j]));
                        u32x4 w; w.x = cvt_pk_bf16(v[0], v[1]); w.y = cvt_pk_bf16(v[2], v[3]); w.z = cvt_pk_bf16(v[4], v[5]); w.w = cvt_pk_bf16(v[6], v[7]);
                        *(u32x4*)(MG + cr * 1024 + col0 + bj * 128) = w;
                    }
                } }
        }
    }
};
struct EpiOut {
    static constexpr bool PERM = false, AFTER_DRAIN = true;
    const float* x; float* out; float* SSQ; unsigned* cnt; const float* fw; unsigned* tmo;
    __device__ __forceinline__ bool zero_after(const Unit&) const { return true; }
    __device__ __forceinline__ void operator()(f32x4 (&acc)[2][2][4][2], const Unit& u, int wr, int wc, int fr, int fq) const {
        const int row0 = u.pm * 256 + wr * 64 + fr, col0 = u.pn * 256 + wc * 32 + 4 * fq;
#pragma unroll
        for (int ai = 0; ai < 2; ++ai)
#pragma unroll
            for (int m = 0; m < 4; ++m) { const size_t cr = (size_t)(row0 + ai * 128 + m * 16); float ss = 0.f;
#pragma unroll
                for (int bj = 0; bj < 2; ++bj)
#pragma unroll
                    for (int n = 0; n < 2; ++n) { const size_t o = cr * 1024 + col0 + bj * 128 + n * 16;
                        const f32x4 h = *(const f32x4*)(x + o) + acc[ai][bj][m][n]; acc[ai][bj][m][n] = h;
                        ss += (h[0] * h[0] + h[1] * h[1]) + (h[2] * h[2] + h[3] * h[3]); }
                ss += __shfl_xor(ss, 16); ss += __shfl_xor(ss, 32);
                if (fq == 0) SSQ[cr * 16 + u.pn * 4 + wc] = ss; }
        asm volatile("s_waitcnt vmcnt(0)" ::: "memory");
        __syncthreads();
        if (threadIdx.x == 0) {
            __builtin_amdgcn_fence(__ATOMIC_RELEASE, "agent");
            asm volatile("s_waitcnt vmcnt(0)" ::: "memory");
            __hip_atomic_fetch_add(cnt + 64 * u.pm, 1u, __ATOMIC_RELAXED, __HIP_MEMORY_SCOPE_AGENT);
            unsigned sp = 0;
            while (__hip_atomic_load(cnt + 64 * u.pm, __ATOMIC_RELAXED, __HIP_MEMORY_SCOPE_AGENT) < 4u) {
                __builtin_amdgcn_s_sleep(1);
                if (++sp > (1u << 22)) { __hip_atomic_store(tmo, 1u, __ATOMIC_RELAXED, __HIP_MEMORY_SCOPE_AGENT); break; } }
            __builtin_amdgcn_fence(__ATOMIC_ACQUIRE, "agent");
            asm volatile("s_waitcnt vmcnt(0)" ::: "memory");
        }
        __syncthreads();
        f32x4 wv[2][2];
#pragma unroll
        for (int bj = 0; bj < 2; ++bj)
#pragma unroll
            for (int n = 0; n < 2; ++n) wv[bj][n] = *(const f32x4*)(fw + col0 + bj * 128 + n * 16);
#pragma unroll
        for (int ai = 0; ai < 2; ++ai)
#pragma unroll
            for (int m = 0; m < 4; ++m) { const size_t cr = (size_t)(row0 + ai * 128 + m * 16);
                const f32x4 s0 = __builtin_nontemporal_load((const f32x4*)(SSQ + cr * 16)), s1 = __builtin_nontemporal_load((const f32x4*)(SSQ + cr * 16 + 4)),
                            s2 = __builtin_nontemporal_load((const f32x4*)(SSQ + cr * 16 + 8)), s3 = __builtin_nontemporal_load((const f32x4*)(SSQ + cr * 16 + 12));
                const f32x4 st = (s0 + s1) + (s2 + s3);
                const float rs = rsqrtf(((st[0] + st[1]) + (st[2] + st[3])) * (1.0f / 1024.0f) + EPS);
#pragma unroll
                for (int bj = 0; bj < 2; ++bj)
#pragma unroll
                    for (int n = 0; n < 2; ++n) { const size_t o = cr * 1024 + col0 + bj * 128 + n * 16; const f32x4 h = acc[ai][bj][m][n];
                        *(f32x4*)(out + o) = (f32x4){h[0] * rs * wv[bj][n][0], h[1] * rs * wv[bj][n][1], h[2] * rs * wv[bj][n][2], h[3] * rs * wv[bj][n][3]}; } }
    }
};
struct EpiOutPlain {
    static constexpr bool PERM = false, AFTER_DRAIN = false;
    const float* x; float* out; float* SSQ;
    __device__ __forceinline__ bool zero_after(const Unit&) const { return true; }
    __device__ __forceinline__ void operator()(f32x4 (&acc)[2][2][4][2], const Unit& u, int wr, int wc, int fr, int fq) const {
        const int row0 = u.pm * 256 + wr * 64 + fr, col0 = u.pn * 256 + wc * 32 + 4 * fq;
#pragma unroll
        for (int ai = 0; ai < 2; ++ai)
#pragma unroll
            for (int m = 0; m < 4; ++m) { const size_t cr = (size_t)(row0 + ai * 128 + m * 16); float ss = 0.f;
#pragma unroll
                for (int bj = 0; bj < 2; ++bj)
#pragma unroll
                    for (int n = 0; n < 2; ++n) { const size_t o = cr * 1024 + col0 + bj * 128 + n * 16;
                        const f32x4 h = *(const f32x4*)(x + o) + acc[ai][bj][m][n]; *(f32x4*)(out + o) = h;
                        ss += (h[0] * h[0] + h[1] * h[1]) + (h[2] * h[2] + h[3] * h[3]); }
                ss += __shfl_xor(ss, 16); ss += __shfl_xor(ss, 32);
                if (fq == 0) SSQ[cr * 16 + u.pn * 4 + wc] = ss; }
    }
};

__device__ __forceinline__ int win_col(int np) {
    const int pn = np >> 8, l = np & 255, bj = l >> 7, w = l & 127;
    if (pn < 16) return np;
    if (pn < 32) return (bj ? OFF_ZA : OFF_O) + 128 * (pn - 16) + w;
    if (pn < 64) {
        const int wc = (l >> 5) & 3, fq = (l >> 3) & 3, n = (l >> 2) & 1, jj = l & 3, q = bj * 2 + n;
        const int off = q == 0 ? OFF_SH : q == 1 ? OFF_SC : q == 2 ? OFF_SB : OFF_ZS;
        return off + 64 * (pn - 32) + 16 * wc + 4 * fq + jj; }
    if (pn < 68) return OFF_GA + 256 * (pn - 64) + l;
    return OFF_GB + 256 * (pn - 68) + l;
}
__device__ void phase_prep(LAS unsigned char* lds, const Args& a) {
    const int tid = threadIdx.x, wid = tid >> 6, lane = tid & 63;
    LAS float* tile = (LAS float*)lds;
    LAS float* wg = (LAS float*)(lds + 256 * 65 * 4);
    bf16_t* WINT = (bf16_t*)(a.ws + WS_WINT); bf16_t* WAT = (bf16_t*)(a.ws + WS_WAT); bf16_t* WBT = (bf16_t*)(a.ws + WS_WBT); bf16_t* WOT = (bf16_t*)(a.ws + WS_WOT);
#define TR_DECODE(job, src, dst, lds_, col0, n0, k0, Kd) \
        if (job < 1152) { const int jn = job >> 2, jk = job & 3; n0 = jn * 64; k0 = jk * 256; src = a.w_in; lds_ = NIN; col0 = win_col(n0); dst = WINT; Kd = 1024; } \
        else if (job < 1408) { const int j = job - 1152, which = j >> 7, jj = j & 127, jn = jj >> 3, jk = jj & 7; n0 = jn * 64; k0 = jk * 256; src = which ? a.w_pb : a.w_pa; lds_ = 1024; col0 = n0; dst = which ? WBT : WAT; Kd = 2048; } \
        else { const int j = job - 1408, jn = j >> 2, jk = j & 3; n0 = jn * 64; k0 = jk * 256; src = a.w_out; lds_ = 1024; col0 = n0; dst = WOT; Kd = 1024; }
    {
        f32x4 v[8];
        int job = blockIdx.x;
        if (job < 1472) { const float* src; bf16_t* dst; int lds_, col0, n0, k0, Kd; TR_DECODE(job, src, dst, lds_, col0, n0, k0, Kd); (void)dst; (void)Kd;
#pragma unroll
            for (int i = 0; i < 8; ++i) { const int idx = tid + 512 * i, kr = idx >> 4, c4 = idx & 15; v[i] = *(const f32x4*)(src + (size_t)(k0 + kr) * lds_ + (job < 1152 ? win_col(n0 + 4 * c4) : col0 + 4 * c4)); } }
        for (; job < 1472; job += gridDim.x) {
            const float* src; bf16_t* dst; int lds_, col0, n0, k0, Kd; TR_DECODE(job, src, dst, lds_, col0, n0, k0, Kd); (void)src; (void)lds_; (void)col0;
#pragma unroll
            for (int i = 0; i < 8; ++i) { const int idx = tid + 512 * i, kr = idx >> 4, c4 = idx & 15;
                tile[kr * 65 + 4 * c4 + 0] = v[i][0]; tile[kr * 65 + 4 * c4 + 1] = v[i][1]; tile[kr * 65 + 4 * c4 + 2] = v[i][2]; tile[kr * 65 + 4 * c4 + 3] = v[i][3]; }
            const int nj = job + gridDim.x;
            if (nj < 1472) { const float* src2; bf16_t* dst2; int lds2, col2, n2, k2, Kd2; TR_DECODE(nj, src2, dst2, lds2, col2, n2, k2, Kd2); (void)dst2; (void)Kd2;
#pragma unroll
                for (int i = 0; i < 8; ++i) { const int idx = tid + 512 * i, kr = idx >> 4, c4 = idx & 15; v[i] = *(const f32x4*)(src2 + (size_t)(k2 + kr) * lds2 + (nj < 1152 ? win_col(n2 + 4 * c4) : col2 + 4 * c4)); } }
            __syncthreads();
            { const int n = tid >> 3, seg = tid & 7;
#pragma unroll
              for (int kq = 0; kq < 4; ++kq) { float f[8];
#pragma unroll
                for (int j = 0; j < 8; ++j) f[j] = tile[(64 * kq + 8 * seg + j) * 65 + n];
                u32x4 w; w.x = cvt_pk_bf16(f[0], f[1]); w.y = cvt_pk_bf16(f[2], f[3]); w.z = cvt_pk_bf16(f[4], f[5]); w.w = cvt_pk_bf16(f[6], f[7]);
                *(u32x4*)(dst + (size_t)(n0 + n) * Kd + k0 + 64 * kq + 8 * seg) = w; } }
            __syncthreads();
        }
    }
#undef TR_DECODE
    for (int i = tid; i < 8192; i += 512) wg[i] = a.w_in[(size_t)(i >> 3) * NIN + OFF_I + (i & 7)];
    __syncthreads();
    bf16_t* XN = (bf16_t*)(a.ws + WS_XN); float* LI = (float*)(a.ws + WS_LI); float* LF = (float*)(a.ws + WS_LF);
    for (int r = blockIdx.x * 8 + wid; r < MP; r += gridDim.x * 8) {
        const int b = r / LP, p = r - b * LP;
        if (p < PADL) {
#pragma unroll
            for (int i = 0; i < 4; ++i) *(u32x2*)(XN + (size_t)r * 1024 + 256 * i + 4 * lane) = (u32x2){0u, 0u};
            if (lane < 4) { LI[(b * 4 + lane) * LP + p] = -INFINITY; LF[(b * 4 + lane) * LP + p] = 0.f; }
            continue;
        }
        const int pos = p - PADL;
        const float* src = pos < 16 ? a.meta + (size_t)pos * 1024 : a.x + ((size_t)b * SEQ + pos - 16) * 1024;
        f32x4 xv[4]; float ss = 0.f;
#pragma unroll
        for (int i = 0; i < 4; ++i) { xv[i] = *(const f32x4*)(src + 256 * i + 4 * lane); ss += (xv[i][0] * xv[i][0] + xv[i][1] * xv[i][1]) + (xv[i][2] * xv[i][2] + xv[i][3] * xv[i][3]); }
        ss = wave_sum(ss);
        const float rs = rsqrtf(ss * (1.0f / 1024.0f) + EPS);
        float g[8] = {0.f, 0.f, 0.f, 0.f, 0.f, 0.f, 0.f, 0.f};
#pragma unroll
        for (int i = 0; i < 4; ++i) { const f32x4 nw = *(const f32x4*)(a.norm_w + 256 * i + 4 * lane);
            f32x4 y; y[0] = xv[i][0] * rs * nw[0]; y[1] = xv[i][1] * rs * nw[1]; y[2] = xv[i][2] * rs * nw[2]; y[3] = xv[i][3] * rs * nw[3];
            *(u32x2*)(XN + (size_t)r * 1024 + 256 * i + 4 * lane) = (u32x2){cvt_pk_bf16(y[0], y[1]), cvt_pk_bf16(y[2], y[3])};
#pragma unroll
            for (int j = 0; j < 4; ++j) { const int k = 256 * i + 4 * lane + j; const f32x4 w0 = *(const LAS f32x4*)(wg + k * 8), w1 = *(const LAS f32x4*)(wg + k * 8 + 4);
                g[0] += y[j] * w0[0]; g[1] += y[j] * w0[1]; g[2] += y[j] * w0[2]; g[3] += y[j] * w0[3]; g[4] += y[j] * w1[0]; g[5] += y[j] * w1[1]; g[6] += y[j] * w1[2]; g[7] += y[j] * w1[3]; } }
#pragma unroll
        for (int j = 0; j < 8; ++j) g[j] = wave_sum(g[j]);
        if (lane < 4) {
            const float ip = (lane == 0 ? g[0] : lane == 1 ? g[1] : lane == 2 ? g[2] : g[3]) + a.b_i[lane];
            const float fp = (lane == 0 ? g[4] : lane == 1 ? g[5] : lane == 2 ? g[6] : g[7]) + a.b_f[lane];
            const float li = 15.0f * tanhf(ip * (1.0f / 15.0f));
            const float fc = 15.0f * tanhf(fp * (1.0f / 15.0f));
            const float lf = fminf(fc, 0.f) - log1pf(expf(-fabsf(fc)));
            LI[(b * 4 + lane) * LP + p] = li; LF[(b * 4 + lane) * LP + p] = lf;
        }
    }
}


__device__ void gate_summaries(const Args& a) {
    const int wid = threadIdx.x >> 6, lane = threadIdx.x & 63;
    const float* LI = (const float*)(a.ws + WS_LI); const float* LF = (const float*)(a.ws + WS_LF); float* SUM = (float*)(a.ws + WS_SUM);
    for (int j = blockIdx.x * 8 + wid; j < NITEM; j += gridDim.x * 8) {
        const int bh = j / NCH, c = j - bh * NCH;
        const float lf = LF[bh * LP + 64 * c + lane], li = LI[bh * LP + 64 * c + lane];
        const float bc = wave_scan_add(lf, lane); const float bl = __shfl(bc, 63); const float av = wave_max(bl - bc + li);
        if (lane == 0) { SUM[2 * j] = bl; SUM[2 * j + 1] = av; }
    }
}

__device__ void phase_prepass(LAS unsigned char* lds, const Args& a) {
    const int tid = threadIdx.x, wid = tid >> 6, lane = tid & 63, e16 = lane & 15, g = lane >> 4;
    LAS float* sm = (LAS float*)lds;
    const bf16_t* QB = (const bf16_t*)(a.ws + WS_R1); const bf16_t* KB = QB + (size_t)MP * 1024;
    const float* LI = (const float*)(a.ws + WS_LI); const float* LF = (const float*)(a.ws + WS_LF); const float* SUM = (const float*)(a.ws + WS_SUM);
    float* EMT = (float*)(a.ws + WS_EMT); float* DECAY = (float*)(a.ws + WS_DECAY); float* KWSUM = (float*)(a.ws + WS_KWS); float* RW = (float*)(a.ws + WS_RW);
    bf16_t* QF = (bf16_t*)(a.ws + WS_R3); bf16_t* KWTF = QF + (size_t)NITEM * 16384; bf16_t* WF = KWTF + (size_t)NITEM * 16384;
    int par = 0;
    for (int item = blockIdx.x; item < NITEM; item += gridDim.x, par ^= 1) {
        const int bh = item / NCH, c = item - bh * NCH, b = bh >> 2, h = bh & 3;
        const size_t row0 = (size_t)b * LP + 64 * c;
        LAS float* kws = sm + 320 + par * 320; LAS float* rw = kws + 256;
        if (tid < 256) kws[tid] = 0.f;
        if (tid >= 256 && tid < 320) rw[tid - 256] = 0.f;
        const int tt = wid >> 1;
        f32x4 acc[2];
        {
            bf16x8 qa[8], kb[2][8];
            const bf16_t* qp = QB + (row0 + 16 * tt + e16) * 1024 + h * 256 + 8 * g;
#pragma unroll
            for (int kk = 0; kk < 8; ++kk) qa[kk] = *(const bf16x8*)(qp + 32 * kk);
#pragma unroll
            for (int q = 0; q < 2; ++q) { const int st = (wid & 1) * 2 + q; const bf16_t* kp = KB + (row0 + 16 * st + e16) * 1024 + h * 256 + 8 * g;
#pragma unroll
                for (int kk = 0; kk < 8; ++kk) kb[q][kk] = *(const bf16x8*)(kp + 32 * kk); }
            asm volatile("" : "+v"(qa[0]), "+v"(qa[7]), "+v"(kb[0][0]), "+v"(kb[1][7]));
#pragma unroll
            for (int q = 0; q < 2; ++q) { acc[q] = (f32x4){0.f, 0.f, 0.f, 0.f};
#pragma unroll
                for (int kk = 0; kk < 8; ++kk) acc[q] = __builtin_amdgcn_mfma_f32_16x16x32_bf16(qa[kk], kb[q][kk], acc[q], 0, 0, 0); }
        }
        if (wid == 1) {
            const float* lip = LI + bh * LP; const float* lfp = LF + bh * LP;
            float B = (lane < c) ? SUM[2 * (bh * NCH + lane)] : 0.f, A = (lane < c) ? SUM[2 * (bh * NCH + lane) + 1] : -INFINITY;
            const float lf = lfp[64 * c + lane], li = lip[64 * c + lane];
#pragma unroll
            for (int o = 1; o < 64; o <<= 1) { const float Bp = __shfl_up(B, o), Ap = __shfl_up(A, o); if (lane >= o) { A = fmaxf(Ap + B, A); B = Bp + B; } }
            float mprev = 0.f;
            if (c > 0) { const float mB = __shfl(B, c - 1), mA = __shfl(A, c - 1); mprev = fmaxf(mB, mA); }
            const float bc = wave_scan_add(lf, lane);
            const float pm = wave_scan_max(li - bc, lane);
            const float mm = fmaxf(mprev, pm), mt = bc + mm, wi = __expf(mprev - mm);
            const float bl = __shfl(bc, 63), mnew = __shfl(mt, 63);
            const float kw = __expf(bl - bc + li - mnew);
            sm[lane] = bc; sm[64 + lane] = li; sm[128 + lane] = mt; sm[192 + lane] = wi; sm[256 + lane] = kw;
            EMT[bh * LP + 64 * c + lane] = __expf(-mt);
            if (lane == 63) DECAY[item] = wi;
        }
        __syncthreads();
        if (c > 0)
#pragma unroll
        for (int q = 0; q < 2; ++q) {
            const int st = (wid & 1) * 2 + q;
            const int s = 16 * st + e16; const float bs = sm[s], lis = sm[64 + s];
#pragma unroll
            for (int r = 0; r < 4; ++r) { const int t = 16 * tt + 4 * g + r;
                float v = 0.f;
                if (s <= t) v = __expf(sm[t] - bs + lis - sm[128 + t]) * acc[q][r];
                const int ks = s >> 5, lp = (t & 15) + 16 * ((s & 31) >> 3), j = s & 7;
                WF[(size_t)item * 4096 + ((tt * 2 + ks) * 64 + lp) * 8 + j] = (bf16_t)(cvt_pk_bf16(v, 0.f) & 0xffffu);
                const float rs = row_sum16(v);
                if (e16 == 0 && st <= tt) __hip_atomic_fetch_add(rw + t, rs, __ATOMIC_RELAXED, __HIP_MEMORY_SCOPE_WORKGROUP); }
        }
        {
            u32x2 qlo[4], qhi[4]; unsigned short kraw[4][8];
#pragma unroll
            for (int i = 0; i < 4; ++i) {
                const int slot = tid + 512 * i, lp = slot & 63, ft = slot >> 6, le = lp & 15, lg = lp >> 4;
                if (c > 0) { const int kk = ft >> 2, tq = ft & 3, t = 16 * tq + le;
                    const bf16_t* qp = QB + (row0 + t) * 1024 + h * 256 + 32 * kk + 4 * lg; qlo[i] = *(const u32x2*)qp; qhi[i] = *(const u32x2*)(qp + 16); }
                else { qlo[i] = (u32x2){0u, 0u}; qhi[i] = (u32x2){0u, 0u}; }
                { const int ks = ft & 1, d = 16 * (ft >> 1) + le;
#pragma unroll
                  for (int j = 0; j < 8; ++j) kraw[i][j] = KB[(row0 + 32 * ks + 8 * lg + j) * 1024 + h * 256 + d]; }
            }
#pragma unroll
            for (int i = 0; i < 4; ++i) {
                const int slot = tid + 512 * i, lp = slot & 63, ft = slot >> 6, le = lp & 15, lg = lp >> 4;
                if (c > 0) { const int tq = ft & 3, t = 16 * tq + le; const float wi = sm[192 + t]; const u32x2 lo = qlo[i], hi = qhi[i];
                    u32x4 w; w.x = cvt_pk_bf16(bf_lo(lo.x) * wi, bf_hi(lo.x) * wi); w.y = cvt_pk_bf16(bf_lo(lo.y) * wi, bf_hi(lo.y) * wi);
                    w.z = cvt_pk_bf16(bf_lo(hi.x) * wi, bf_hi(hi.x) * wi); w.w = cvt_pk_bf16(bf_lo(hi.y) * wi, bf_hi(hi.y) * wi);
                    *(u32x4*)(QF + (size_t)item * 16384 + (size_t)slot * 8) = w; }
                { const int ks = ft & 1, d = 16 * (ft >> 1) + le; float f[8];
#pragma unroll
                  for (int j = 0; j < 8; ++j) f[j] = sm[256 + 32 * ks + 8 * lg + j] * bf2f(kraw[i][j]);
                  u32x4 w; w.x = cvt_pk_bf16(f[0], f[1]); w.y = cvt_pk_bf16(f[2], f[3]); w.z = cvt_pk_bf16(f[4], f[5]); w.w = cvt_pk_bf16(f[6], f[7]);
                  *(u32x4*)(KWTF + (size_t)item * 16384 + (size_t)slot * 8) = w;
                  float ssum = ((f[0] + f[1]) + (f[2] + f[3])) + ((f[4] + f[5]) + (f[6] + f[7]));
                  ssum += __shfl_xor(ssum, 16); ssum += __shfl_xor(ssum, 32);
                  if (lg == 0) __hip_atomic_fetch_add(kws + d, ssum, __ATOMIC_RELAXED, __HIP_MEMORY_SCOPE_WORKGROUP); }
            }
        }
        __syncthreads();
        if (tid < 256) KWSUM[(size_t)item * 256 + tid] = kws[tid];
        if (tid >= 256 && tid < 320) RW[(size_t)item * 64 + tid - 256] = rw[tid - 256];
    }
}

__device__ void phase_scan(LAS unsigned char* lds, const Args& a, const bool fuse_stats) {
    const int tid = threadIdx.x, wid = __builtin_amdgcn_readfirstlane(tid >> 6), lane = tid & 63, e16 = lane & 15, g = lane >> 4;
    LAS f32x4* red = (LAS f32x4*)lds;
    LAS unsigned char* vl = lds + 131072;
    LAS float* npv = (LAS float*)(lds + 131072 + 2 * 4608);
    LAS float* decl = (LAS float*)(lds + LDS_DEC_OFF);
    const bf16_t* VB = (const bf16_t*)(a.ws + WS_R2);
    const bf16_t* QF = (const bf16_t*)(a.ws + WS_R3); const bf16_t* KWTF = QF + (size_t)NITEM * 16384; const bf16_t* WF = KWTF + (size_t)NITEM * 16384;
    const float* DECAY = (const float*)(a.ws + WS_DECAY); const float* KWSUM = (const float*)(a.ws + WS_KWS); const float* RW = (const float*)(a.ws + WS_RW);
    bf16_t* HN = (bf16_t*)(a.ws + WS_R1); float* DEN = (float*)(a.ws + WS_DEN);
    const int G = gridDim.x; const int vc = (G == 256) ? (((int)blockIdx.x & 7) * 32 + ((int)blockIdx.x >> 3)) : (int)blockIdx.x;
    const int ttw = wid >> 1, ksw = wid & 1;
    for (int job = vc; job < 256; job += G) {
        const int bh = job >> 4, sl = job & 15, b = bh >> 2, h = bh & 3;
        if (tid >= 256 && tid < 256 + NCH) decl[tid - 256] = DECAY[bh * NCH + tid - 256];
        if (tid < 256) { float n = 0.f; float kv[NCH];
#pragma unroll
            for (int c = 0; c < NCH; ++c) kv[c] = KWSUM[(size_t)(bh * NCH + c) * 256 + tid];
#pragma unroll
            for (int c = 0; c < NCH; ++c) { if ((c & 15) == sl) npv[(c >> 4) * 256 + tid] = n; n = DECAY[bh * NCH + c] * n + kv[c]; } }
        __syncthreads();
        for (int ci = 0; 16 * ci + sl < NCH; ++ci) {
            const int c = 16 * ci + sl, item = bh * NCH + c, t = tid >> 3, kk = tid & 7; float dot = 0.f;
#pragma unroll
            for (int lg = 0; lg < 4; ++lg) { const u32x4 q = *(const u32x4*)(QF + (size_t)item * 16384 + ((kk * 4 + (t >> 4)) * 64 + (t & 15) + 16 * lg) * 8);
                const float qv[8] = {bf_lo(q.x), bf_hi(q.x), bf_lo(q.y), bf_hi(q.y), bf_lo(q.z), bf_hi(q.z), bf_lo(q.w), bf_hi(q.w)};
#pragma unroll
                for (int j = 0; j < 8; ++j) dot += qv[j] * npv[ci * 256 + 32 * kk + 16 * (j >> 2) + 4 * lg + (j & 3)]; }
            dot += __shfl_xor(dot, 1); dot += __shfl_xor(dot, 2); dot += __shfl_xor(dot, 4);
            if (kk == 0 && c >= 1) DEN[((size_t)b * SEQ + 64 * (c - 1) + t) * 4 + h] = dot + RW[(size_t)item * 64 + t];
        }
        f32x4 C[2][2];
#pragma unroll
        for (int i = 0; i < 2; ++i)
#pragma unroll
            for (int j = 0; j < 2; ++j) C[i][j] = (f32x4){0.f, 0.f, 0.f, 0.f};
        const int vrow = tid >> 3, vcq = tid & 7;
        struct OpSet { bf16x8 k[4], w; float d; };
        OpSet R0, R1; bf16x8 Q0[4], Q1[4], Q2[4]; u32x2 V0, V1, V2;
        const bf16_t* vgp = VB + ((size_t)b * LP + vrow) * 2048 + h * 512 + 32 * sl + 4 * vcq;
        const bf16_t* qgp = QF + (size_t)bh * NCH * 16384 + (wid * 256 + lane) * 8;
        const bf16_t* kgp = KWTF + (size_t)bh * NCH * 16384 + (wid * 256 + lane) * 8;
        const bf16_t* wgp = WF + (size_t)bh * NCH * 4096 + ((ttw * 2 + ksw) * 64 + lane) * 8;
        const unsigned vrd = (unsigned)(uintptr_t)(vl + (8 * g + ((lane & 15) >> 2)) * 72 + 8 * (lane & 3));
        const unsigned vwr = (unsigned)(vrow * 72 + vcq * 8);
#define SC_LOADK(R, cc) do { _Pragma("unroll") for (int i_ = 0; i_ < 4; ++i_) R.k[i_] = *(const bf16x8*)(kgp + (size_t)(cc) * 16384 + i_ * 512); \
            R.w = *(const bf16x8*)(wgp + (size_t)(cc) * 4096); \
            R.d = decl[(cc)]; } while (0)
#define SC_LOADQ(Q, V, cc) do { V = *(const u32x2*)(vgp + (size_t)(cc) * (64 * 2048)); \
            _Pragma("unroll") for (int tt_ = 0; tt_ < 4; ++tt_) Q[tt_] = *(const bf16x8*)(qgp + (size_t)(cc) * 16384 + tt_ * 512); } while (0)
#define SC_TR(dst, off) asm volatile("ds_read_b64_tr_b16 %0, %1 offset:%2" : "=&v"(dst) : "v"(vaddr), "i"(off) : "memory")
#define SC_STEP(c, CUR, NX, QC, QL, VN, VL) do { if ((c) < NCH) { \
            const int buf = (c) & 1; \
            if ((c) + 1 < NCH) SC_LOADK(NX, (c) + 1); \
            if ((c) + 2 < NCH) SC_LOADQ(QL, VL, (c) + 2); \
            union { u32x2 h[2]; bf16x8 v; } vfu[2][2]; \
            { const unsigned vaddr = vrd + buf * 4608; \
              SC_TR(vfu[0][0].h[0], 0); SC_TR(vfu[0][0].h[1], 288); SC_TR(vfu[0][1].h[0], 32); SC_TR(vfu[0][1].h[1], 320); \
              SC_TR(vfu[1][0].h[0], 2304); SC_TR(vfu[1][0].h[1], 2592); SC_TR(vfu[1][1].h[0], 2336); SC_TR(vfu[1][1].h[1], 2624); \
              asm volatile("s_waitcnt lgkmcnt(0)" ::: "memory"); } \
            bf16x8 cf[2]; \
            _Pragma("unroll") for (int et = 0; et < 2; ++et) { union { u32x4 u; bf16x8 v; } cu; \
                cu.u.x = cvt_pk_bf16(C[0][et][0], C[0][et][1]); cu.u.y = cvt_pk_bf16(C[0][et][2], C[0][et][3]); \
                cu.u.z = cvt_pk_bf16(C[1][et][0], C[1][et][1]); cu.u.w = cvt_pk_bf16(C[1][et][2], C[1][et][3]); cf[et] = cu.v; } \
            f32x4 num[4][2]; \
            _Pragma("unroll") for (int tt = 0; tt < 4; ++tt) _Pragma("unroll") for (int et = 0; et < 2; ++et) \
                num[tt][et] = __builtin_amdgcn_mfma_f32_16x16x32_bf16(QC[tt], cf[et], (f32x4){0.f, 0.f, 0.f, 0.f}, 0, 0, 0); \
            _Pragma("unroll") for (int tt = 0; tt < 4; ++tt) _Pragma("unroll") for (int ks = 0; ks < 2; ++ks) if (tt == ttw && ks == ksw) { \
                _Pragma("unroll") for (int et = 0; et < 2; ++et) num[tt][et] = __builtin_amdgcn_mfma_f32_16x16x32_bf16(CUR.w, vfu[ks][et].v, num[tt][et], 0, 0, 0); } \
            _Pragma("unroll") for (int dl = 0; dl < 2; ++dl) _Pragma("unroll") for (int et = 0; et < 2; ++et) { C[dl][et] = C[dl][et] * CUR.d; \
                _Pragma("unroll") for (int ks = 0; ks < 2; ++ks) C[dl][et] = __builtin_amdgcn_mfma_f32_16x16x32_bf16(CUR.k[dl * 2 + ks], vfu[ks][et].v, C[dl][et], 0, 0, 0); } \
            _Pragma("unroll") for (int tt = 0; tt < 4; ++tt) _Pragma("unroll") for (int et = 0; et < 2; ++et) red[((buf * 8 + wid) * 8 + tt * 2 + et) * 64 + lane] = num[tt][et]; \
            if ((c) + 1 < NCH) *(LAS u32x2*)(vl + (buf ^ 1) * 4608 + vwr) = VN; \
            asm volatile("s_waitcnt lgkmcnt(0)" ::: "memory"); __builtin_amdgcn_s_barrier(); asm volatile("" ::: "memory"); \
            if ((c) >= 1) { \
                f32x4 tot = red[((buf * 8 + 0) * 8 + wid) * 64 + lane]; \
                _Pragma("unroll") for (int w2 = 1; w2 < 8; ++w2) tot += red[((buf * 8 + w2) * 8 + wid) * 64 + lane]; \
                const size_t cr0 = (size_t)b * SEQ + 64 * ((c) - 1) + 16 * ttw + 4 * g; \
                bf16_t* hp = HN + cr0 * 2048 + h * 512 + 32 * sl + 16 * ksw + e16; \
                _Pragma("unroll") for (int r = 0; r < 4; ++r) hp[(size_t)r * 2048] = (bf16_t)(cvt_pk_bf16(tot[r], 0.f) & 0xffffu); } \
        } } while (0)
        SC_LOADK(R0, 0); SC_LOADQ(Q0, V0, 0); SC_LOADQ(Q1, V1, 1);
        *(LAS u32x2*)(vl + vwr) = V0;
        __syncthreads();
        for (int c0 = 0; c0 < NCH; c0 += 6) {
            SC_STEP(c0,     R0, R1, Q0, Q2, V1, V2);
            SC_STEP(c0 + 1, R1, R0, Q1, Q0, V2, V0);
            SC_STEP(c0 + 2, R0, R1, Q2, Q1, V0, V1);
            SC_STEP(c0 + 3, R1, R0, Q0, Q2, V1, V2);
            SC_STEP(c0 + 4, R0, R1, Q1, Q0, V2, V0);
            SC_STEP(c0 + 5, R1, R0, Q2, Q1, V0, V1);
        }
#undef SC_LOADK
#undef SC_LOADQ
#undef SC_STEP
#undef SC_TR
        __syncthreads();
        if (fuse_stats) {
            unsigned* cntb = (unsigned*)(a.ws + WS_BAR) + 7680 + 64 * bh;
            asm volatile("s_waitcnt vmcnt(0)" ::: "memory");
            __syncthreads();
            if (tid == 0) {
                __builtin_amdgcn_fence(__ATOMIC_RELEASE, "agent");
                asm volatile("s_waitcnt vmcnt(0)" ::: "memory");
                __hip_atomic_fetch_add(cntb, 1u, __ATOMIC_RELAXED, __HIP_MEMORY_SCOPE_AGENT);
                unsigned sp = 0;
                while (__hip_atomic_load(cntb, __ATOMIC_RELAXED, __HIP_MEMORY_SCOPE_AGENT) < 16u) { __builtin_amdgcn_s_sleep(1);
                    if (++sp > (1u << 22)) { __hip_atomic_store((unsigned*)(a.ws + WS_BAR) + XB_TMO, 1u, __ATOMIC_RELAXED, __HIP_MEMORY_SCOPE_AGENT); break; } }
                __builtin_amdgcn_fence(__ATOMIC_ACQUIRE, "agent");
                asm volatile("s_waitcnt vmcnt(0)" ::: "memory");
            }
            __syncthreads();
            const float* EMTp = (const float*)(a.ws + WS_EMT); float* SCp = (float*)(a.ws + WS_SC);
            for (int r0 = 32 * wid; r0 < 32 * wid + 32; r0 += 4) {
                u32x4 hv[4]; float dn[4], em[4];
#pragma unroll
                for (int q = 0; q < 4; ++q) { const int sr = 256 * sl + r0 + q; const size_t cr = (size_t)b * SEQ + sr;
                    hv[q] = *(const u32x4*)(HN + cr * 2048 + h * 512 + 8 * lane); dn[q] = DEN[cr * 4 + h]; em[q] = EMTp[bh * LP + 64 + sr]; }
#pragma unroll
                for (int q = 0; q < 4; ++q) { const int sr = 256 * sl + r0 + q; const size_t cr = (size_t)b * SEQ + sr;
                    const float inv = 1.0f / fmaxf(fabsf(dn[q]), em[q]);
                    const float f[8] = {bf_lo(hv[q].x), bf_hi(hv[q].x), bf_lo(hv[q].y), bf_hi(hv[q].y), bf_lo(hv[q].z), bf_hi(hv[q].z), bf_lo(hv[q].w), bf_hi(hv[q].w)};
                    float ss = 0.f;
#pragma unroll
                    for (int j = 0; j < 8; ++j) { const float v = f[j] * inv; ss += v * v; }
                    ss = wave_sum(ss);
                    if (lane == 0) SCp[cr * 4 + h] = rsqrtf(ss * (1.0f / 512.0f) + EPS) * inv; }
            }
            __syncthreads();
        }
    }
}

__device__ void phase_stats(const Args& a) {
    const int wid = threadIdx.x >> 6, lane = threadIdx.x & 63;
    const bf16_t* HN = (const bf16_t*)(a.ws + WS_R1); const float* DEN = (const float*)(a.ws + WS_DEN); const float* EMT = (const float*)(a.ws + WS_EMT); float* SC = (float*)(a.ws + WS_SC);
    for (int cr = blockIdx.x * 8 + wid; cr < MC; cr += gridDim.x * 8) {
        const int b = cr >> 12, s = cr & 4095;
        u32x4 hv[4];
#pragma unroll
        for (int h = 0; h < 4; ++h) hv[h] = *(const u32x4*)(HN + (size_t)cr * 2048 + h * 512 + 8 * lane);
        const f32x4 den = *(const f32x4*)(DEN + (size_t)cr * 4);
        float em[4];
#pragma unroll
        for (int h = 0; h < 4; ++h) em[h] = EMT[(b * 4 + h) * LP + 64 + s];
        float res[4];
#pragma unroll
        for (int h = 0; h < 4; ++h) {
            const float inv = 1.0f / fmaxf(fabsf(den[h]), em[h]);
            const float f[8] = {bf_lo(hv[h].x), bf_hi(hv[h].x), bf_lo(hv[h].y), bf_hi(hv[h].y), bf_lo(hv[h].z), bf_hi(hv[h].z), bf_lo(hv[h].w), bf_hi(hv[h].w)};
            float ss = 0.f;
#pragma unroll
            for (int j = 0; j < 8; ++j) { const float v = f[j] * inv; ss += v * v; }
            ss = wave_sum(ss);
            res[h] = rsqrtf(ss * (1.0f / 512.0f) + EPS) * inv;
        }
        if (lane == 0) *(f32x4*)(SC + (size_t)cr * 4) = (f32x4){res[0], res[1], res[2], res[3]};
    }
}

__device__ __forceinline__ void conv_fix(const Args& a, int G, int i, size_t cr, int ch) {
    const bf16_t* UB = (const bf16_t*)(a.ws + WS_R3); const bf16_t* UF = UB + (size_t)260 * 2 * 2048; const bf16_t* GSB = UF + (size_t)260 * 2 * 2048; bf16_t* YS = (bf16_t*)(a.ws + WS_R2);
    const u32x4 u0 = *(const u32x4*)(UF + ((size_t)G * 2 + i) * 2048 + ch), gs = *(const u32x4*)(GSB + ((size_t)G * 2 + i) * 2048 + ch);
    const u32x4 u1 = i ? *(const u32x4*)(UF + ((size_t)G * 2) * 2048 + ch) : *(const u32x4*)(UB + ((size_t)(G - 1) * 2 + 1) * 2048 + ch);
    const u32x4 u2 = i ? *(const u32x4*)(UB + ((size_t)(G - 1) * 2 + 1) * 2048 + ch) : *(const u32x4*)(UB + ((size_t)(G - 1) * 2) * 2048 + ch);
    const unsigned u0w[4] = {u0.x, u0.y, u0.z, u0.w}, u1w[4] = {u1.x, u1.y, u1.z, u1.w}, u2w[4] = {u2.x, u2.y, u2.z, u2.w}, gw[4] = {gs.x, gs.y, gs.z, gs.w};
    unsigned ow[4];
#pragma unroll
    for (int q = 0; q < 4; ++q) { const int c0 = ch + 2 * q;
        const float ya = bf_lo(gw[q]) * (a.conv_w[c0] * bf_lo(u2w[q]) + a.conv_w[2048 + c0] * bf_lo(u1w[q]) + a.conv_w[4096 + c0] * bf_lo(u0w[q]));
        const float yb = bf_hi(gw[q]) * (a.conv_w[c0 + 1] * bf_hi(u2w[q]) + a.conv_w[2048 + c0 + 1] * bf_hi(u1w[q]) + a.conv_w[4096 + c0 + 1] * bf_hi(u0w[q]));
        ow[q] = cvt_pk_bf16(ya, yb); }
    *(u32x4*)(YS + cr * 2048 + ch) = (u32x4){ow[0], ow[1], ow[2], ow[3]};
}
__device__ void phase_conv(const Args& a) {
    const int wid = threadIdx.x >> 6, lane = threadIdx.x & 63;
    for (int job = blockIdx.x * 8 + wid; job < 260 * 8; job += gridDim.x * 8) {
        const int G = job >> 3, i = (job >> 2) & 1, it = job & 3;
        const int b = (64 * G) / LP, p0 = 64 * G - b * LP; if (p0 < 64) continue;
        conv_fix(a, G, i, (size_t)b * SEQ + p0 - 64 + i, 512 * it + 8 * lane);
    }
}
__device__ void conv_fix_panel(const Args& a, int pm) {
    const int r8 = threadIdx.x >> 6, lane = threadIdx.x & 63, k = r8 >> 1, i = r8 & 1;
    const int b = pm >> 4, s0 = 256 * (pm & 15) + 64 * k, G = b * NCH + 1 + (s0 >> 6);
#pragma unroll
    for (int it = 0; it < 4; ++it) conv_fix(a, G, i, (size_t)b * SEQ + s0 + i, 512 * it + 8 * lane);
    asm volatile("s_waitcnt vmcnt(0)" ::: "memory");
    __syncthreads();
}

__device__ void phase_final(const Args& a) {
    const int wid = threadIdx.x >> 6, lane = threadIdx.x & 63;
    const float* SSQ = (const float*)(a.ws + WS_SSQ);
    f32x4 w[4];
#pragma unroll
    for (int i = 0; i < 4; ++i) w[i] = *(const f32x4*)(a.fin_w + 256 * i + 4 * lane);
    for (int cr = (blockIdx.x * 8 + wid) * 2; cr < MC; cr += gridDim.x * 16) {
        f32x4 v[2][4]; float ss[2];
#pragma unroll
        for (int q = 0; q < 2; ++q) { ss[q] = (lane < 16) ? SSQ[(size_t)(cr + q) * 16 + lane] : 0.f;
#pragma unroll
            for (int i = 0; i < 4; ++i) v[q][i] = *(const f32x4*)(a.out + (size_t)(cr + q) * 1024 + 256 * i + 4 * lane); }
#pragma unroll
        for (int q = 0; q < 2; ++q) { const float rs = rsqrtf(wave_sum(ss[q]) * (1.0f / 1024.0f) + EPS);
#pragma unroll
            for (int i = 0; i < 4; ++i) *(f32x4*)(a.out + (size_t)(cr + q) * 1024 + 256 * i + 4 * lane) = (f32x4){v[q][i][0] * rs * w[i][0], v[q][i][1] * rs * w[i][1], v[q][i][2] * rs * w[i][2], v[q][i][3] * rs * w[i][3]}; }
    }
}

__global__ void __launch_bounds__(512, 2) fwd(Args a) {
    extern __shared__ __attribute__((aligned(16))) unsigned char lds_raw[];
    LAS unsigned char* lds = (LAS unsigned char*)lds_raw;
    cg::grid_group grid = cg::this_grid();
    const int lo = a.ph_lo, hi = a.ph_hi; const int G = gridDim.x, c = blockIdx.x;
    if (lo < 0) grid.sync();
    volatile LAS unsigned* bst = (volatile LAS unsigned*)(lds + LDS_BAR_OFF);
    if (threadIdx.x == 0) { bst[0] = 0u; bst[1] = 0u; }
    __syncthreads();
    XcdBarrier xbar; xbar.bar = (unsigned*)(a.ws + WS_BAR); xbar.x = 0; xbar.st = bst;
    if (hi - lo > 1) xbar = xcd_barrier_post((unsigned*)(a.ws + WS_BAR), bst);
#define GSYNC() xcd_barrier(xbar)
#define IN(k) (lo <= (k) && (k) < hi)
#if PROBE_A >= 0
    unsigned long long* TS = (unsigned long long*)(a.ws + WS_DECAY + 4160);
#define STAMP(k) do { if (blockIdx.x == 0 && threadIdx.x == 0) TS[k] = __builtin_amdgcn_s_memrealtime(); } while (0)
#else
#define STAMP(k) do { } while (0)
#endif
#define SEAM(k) do { if (IN(k) && IN((k) + 1)) GSYNC(); STAMP((k) + 1); } while (0)
    STAMP(0);
    if (IN(0)) phase_prep(lds, a);
    SEAM(0);
    if (IN(1)) { gate_summaries(a);
        SchedIn S{16, 0, G, c, (const char*)(a.ws + WS_XN), (const char*)(a.ws + WS_WINT)};
        EpiQKV E{(bf16_t*)(a.ws + WS_R1), (bf16_t*)(a.ws + WS_R1) + (size_t)MP * 1024, (bf16_t*)(a.ws + WS_R2)};
        pg8::gemm_phase(lds, 1024, S, E); }
    SEAM(1);
    if (IN(2)) phase_prepass(lds, a);
    SEAM(2);
    const bool fuse34 = (G == 256) && IN(3) && IN(4);
    if (IN(3)) phase_scan(lds, a, fuse34);
    SEAM(3);
    if (!fuse34) { if (IN(4)) phase_stats(a);
        SEAM(4); }
    if (IN(5)) { SchedIn S{56, 16, G, c, (const char*)(a.ws + WS_XN), (const char*)(a.ws + WS_WINT)};
        EpiRest E{(bf16_t*)(a.ws + WS_R1), (const float*)(a.ws + WS_SC), a.mh_w, a.conv_w, (bf16_t*)(a.ws + WS_R3), (bf16_t*)(a.ws + WS_R3) + (size_t)260 * 2 * 2048, (bf16_t*)(a.ws + WS_R3) + (size_t)260 * 4 * 2048, (bf16_t*)(a.ws + WS_R2), (bf16_t*)a.out};
        pg8::gemm_phase(lds, 1024, S, E); }
    SEAM(5);
    const bool fuse67 = IN(6) && IN(7);
    if (!fuse67) { if (IN(6)) phase_conv(a);
        SEAM(6); }
    if (IN(7)) { const int vc = (G == 256) ? ((c & 7) * 32 + (c >> 3)) : c;
        if (fuse67) { for (int tile = vc; tile < 256; tile += G) conv_fix_panel(a, tile >> 2); }
        SchedMerge S{G, vc, (const char*)(a.ws + WS_R1), (const char*)(a.ws + WS_R2), (const char*)(a.ws + WS_WAT), (const char*)(a.ws + WS_WBT)};
        EpiMerge E{(const bf16_t*)a.out, (bf16_t*)(a.ws + WS_XN)};
        pg8::gemm_phase(lds, 2048, S, E); }
    SEAM(7);
    const bool fuse89 = (G == 256) && IN(8) && IN(9);
    if (IN(8)) { const int vc = (G == 256) ? ((c & 7) * 32 + (c >> 3)) : c;
        SchedOut S{G, vc, (const char*)(a.ws + WS_XN), (const char*)(a.ws + WS_WOT)};
        if (fuse89) { EpiOut E{a.x, a.out, (float*)(a.ws + WS_SSQ), (unsigned*)(a.ws + WS_BAR) + XCD_BAR_WORDS + 64, a.fin_w, (unsigned*)(a.ws + WS_BAR) + XB_TMO};
            pg8::gemm_phase(lds, 1024, S, E); }
        else { EpiOutPlain E{a.x, a.out, (float*)(a.ws + WS_SSQ)};
            pg8::gemm_phase(lds, 1024, S, E); } }
    if (!fuse89) { SEAM(8);
        if (IN(9)) phase_final(a); }
#if PROBE_A >= 0
    GSYNC(); STAMP(10); GSYNC();
    { const float ta = (float)(TS[PROBE_A + 1] - TS[PROBE_A]) * 0.01f, tb = (float)(TS[PROBE_B + 1] - TS[PROBE_B]) * 0.01f;
      for (int i = blockIdx.x * 512 + threadIdx.x; i < (1 << 20); i += gridDim.x * 512) a.out[1024 + i] = tb * (1.0f / 32.0f);
      if (blockIdx.x == 0 && threadIdx.x == 0) a.out[0] = ta; }
#endif
#undef IN
#undef SEAM
}

constexpr int NPH = 10;


extern "C" void kernel_launch(void* const* d_in, const int* in_sizes, int n_in, void* d_out, int out_size, void* d_ws, size_t ws_size, hipStream_t stream) {
    static int grid = 0;
    if (grid == 0) {
        int dev = 0, cus = 0, per_cu = 0;
        (void)hipGetDevice(&dev);
        (void)hipDeviceGetAttribute(&cus, hipDeviceAttributeMultiprocessorCount, dev);
        if (hipFuncSetAttribute((const void*)fwd, hipFuncAttributeMaxDynamicSharedMemorySize, LDS_BYTES) != hipSuccess) { fprintf(stderr, "hipFuncSetAttribute failed\n"); grid = -1; return; }
        (void)hipOccupancyMaxActiveBlocksPerMultiprocessor(&per_cu, (const void*)fwd, 512, LDS_BYTES);
        (void)hipGetLastError();
        if (per_cu < 1) per_cu = 1;
        grid = cus * 1;
        if (ws_size < WS_END) fprintf(stderr, "kernel_launch: workspace too small: %zu < %zu\n", ws_size, (size_t)WS_END);
    }
    if (grid < 0) return;
    Args a{};
    a.x = (const float*)d_in[0]; a.meta = (const float*)d_in[1]; a.norm_w = (const float*)d_in[2]; a.w_in = (const float*)d_in[3];
    a.b_i = (const float*)d_in[4]; a.b_f = (const float*)d_in[5]; a.mh_w = (const float*)d_in[6]; a.conv_w = (const float*)d_in[7];
    a.w_pa = (const float*)d_in[8]; a.w_pb = (const float*)d_in[9]; a.w_out = (const float*)d_in[10]; a.fin_w = (const float*)d_in[11];
    a.out = (float*)d_out; a.ws = (unsigned char*)d_ws;
#if SINGLE_LAUNCH
    (void)hipMemsetAsync((unsigned char*)d_ws + WS_BAR, 0, 65536, stream);
    a.ph_lo = 0; a.ph_hi = NPH;
    void* args[] = {&a};
    hipError_t e = hipLaunchCooperativeKernel((const void*)fwd, dim3(grid), dim3(512), args, LDS_BYTES, stream);
    if (e != hipSuccess) fprintf(stderr, "cooperative launch failed: %s (grid %d)\n", hipGetErrorString(e), grid);
#else
    for (int k = 0; k < NPH; ++k) { a.ph_lo = k; a.ph_hi = k + 1; for (int rep = 0; rep < 1 + ((DBL_MASK >> k) & 1); ++rep) hipLaunchKernelGGL(fwd, dim3(grid), dim3(512), LDS_BYTES, stream, a); }
#endif
}
```

```cpp
#include <hip/hip_runtime.h>
#include <hip/hip_cooperative_groups.h>
#include <cstdio>
namespace cg = cooperative_groups;

#ifndef SINGLE_LAUNCH
#define SINGLE_LAUNCH 1
#endif

#ifndef DBL_MASK
#define DBL_MASK 0
#endif
#ifndef PROBE_A
#define PROBE_A -1
#define PROBE_B -1
#endif

#define LAS __attribute__((address_space(3)))
typedef unsigned short bf16_t;
typedef short bf16x8 __attribute__((ext_vector_type(8)));
typedef float f32x4 __attribute__((ext_vector_type(4)));
typedef unsigned u32x4 __attribute__((ext_vector_type(4)));
typedef unsigned u32x2 __attribute__((ext_vector_type(2)));

constexpr int DM = 1024, NB = 4, SEQ = 4096, LP = 4160, PADL = 48, MP = NB * LP, MC = NB * SEQ, NCH = 65, NIN = 18440, NITEM = 16 * NCH;
constexpr int OFF_O = 4096, OFF_ZA = 6144, OFF_I = 8192, OFF_SH = 8200, OFF_SB = 10248, OFF_SC = 12296, OFF_ZS = 14344, OFF_GA = 16392, OFF_GB = 17416;
constexpr float EPS = 1e-6f;

constexpr size_t SZ_XN = (size_t)MP * 1024 * 2, SZ_WINT = (size_t)18432 * 1024 * 2, SZ_W2 = (size_t)1024 * 2048 * 2, SZ_WO = (size_t)1024 * 1024 * 2;
constexpr size_t SZ_G = (size_t)16 * LP * 4, SZ_C4 = (size_t)MC * 4 * 4;
constexpr size_t WS_XN = 0, WS_WINT = WS_XN + SZ_XN, WS_WAT = WS_WINT + SZ_WINT, WS_WBT = WS_WAT + SZ_W2, WS_WOT = WS_WBT + SZ_W2,
                 WS_LI = WS_WOT + SZ_WO, WS_LF = WS_LI + SZ_G, WS_EMT = WS_LF + SZ_G, WS_DEN = WS_EMT + SZ_G, WS_SC = WS_DEN + SZ_C4,
                 WS_DECAY = WS_SC + SZ_C4, WS_SSQ = WS_DECAY + 4352, WS_KWS = WS_SSQ + (size_t)MC * 16 * 4, WS_RW = WS_KWS + (size_t)NITEM * 256 * 4,
                 WS_BAR = WS_RW + (size_t)NITEM * 64 * 4, WS_SUM = WS_BAR + 32768, WS_R1 = WS_SUM + 8448,
                 WS_R2 = WS_R1 + (size_t)MP * 2048 * 2, WS_R3 = WS_R2 + (size_t)MP * 2048 * 2,
                 SZ_QF = (size_t)NITEM * 16384 * 2, SZ_WF = (size_t)NITEM * 4096 * 2, WS_END = WS_R3 + 2 * SZ_QF + SZ_WF;
static_assert(WS_END <= (size_t)4 * 1024 * 18440 * 4, "workspace budget");
static_assert(WS_R1 % 256 == 0 && WS_R3 % 256 == 0, "align");

constexpr int LDS_BAR_OFF = 131072 + 2 * 4608 + 5 * 1024, LDS_DEC_OFF = LDS_BAR_OFF + 16, LDS_BYTES = LDS_DEC_OFF + 272;
struct Args {
    const float* x; const float* meta; const float* norm_w; const float* w_in; const float* b_i; const float* b_f; const float* mh_w;
    const float* conv_w; const float* w_pa; const float* w_pb; const float* w_out; const float* fin_w;
    float* out; unsigned char* ws; int ph_lo, ph_hi;
};

__device__ __forceinline__ unsigned cvt_pk_bf16(float lo, float hi) { unsigned r; asm volatile("v_cvt_pk_bf16_f32 %0, %1, %2" : "=v"(r) : "v"(lo), "v"(hi)); return r; }
__device__ __forceinline__ float bf_lo(unsigned w) { return __uint_as_float(w << 16); }
__device__ __forceinline__ float bf_hi(unsigned w) { return __uint_as_float(w & 0xffff0000u); }
__device__ __forceinline__ float bf2f(bf16_t b) { return __uint_as_float(((unsigned)b) << 16); }
__device__ __forceinline__ float ex2(float x) { return __builtin_amdgcn_exp2f(x); }
__device__ __forceinline__ float en(float x) { return ex2(fminf(-1.4426950409f * x, 100.f)); }
__device__ __forceinline__ float enu(float x) { return ex2(-1.4426950409f * x); }
__device__ __forceinline__ float sigm(float x) { return __builtin_amdgcn_rcpf(1.0f + enu(x)); }
#define DPP_ROR(n) (0x120 | (n))
#define DPP_SHR(n) (0x110 | (n))
template <int CTRL> __device__ __forceinline__ float dpp_f(float oldv, float v) {
    return __int_as_float(__builtin_amdgcn_update_dpp(__float_as_int(oldv), __float_as_int(v), CTRL, 0xf, 0xf, false)); }
__device__ __forceinline__ float rl_f(float v, int l) { return __int_as_float(__builtin_amdgcn_readlane(__float_as_int(v), l)); }
__device__ __forceinline__ float row_sum16(float v) {
    v += dpp_f<DPP_ROR(8)>(v, v); v += dpp_f<DPP_ROR(4)>(v, v); v += dpp_f<DPP_ROR(2)>(v, v); v += dpp_f<DPP_ROR(1)>(v, v); return v; }
__device__ __forceinline__ float row_max16(float v) {
    v = fmaxf(v, dpp_f<DPP_ROR(8)>(v, v)); v = fmaxf(v, dpp_f<DPP_ROR(4)>(v, v)); v = fmaxf(v, dpp_f<DPP_ROR(2)>(v, v)); v = fmaxf(v, dpp_f<DPP_ROR(1)>(v, v)); return v; }
__device__ __forceinline__ float wave_sum(float v) { v = row_sum16(v); return (rl_f(v, 0) + rl_f(v, 16)) + (rl_f(v, 32) + rl_f(v, 48)); }
__device__ __forceinline__ float wave_max(float v) { v = row_max16(v); return fmaxf(fmaxf(rl_f(v, 0), rl_f(v, 16)), fmaxf(rl_f(v, 32), rl_f(v, 48))); }
__device__ __forceinline__ float wave_scan_add(float v, int lane) {
    v += dpp_f<DPP_SHR(1)>(0.f, v); v += dpp_f<DPP_SHR(2)>(0.f, v); v += dpp_f<DPP_SHR(4)>(0.f, v); v += dpp_f<DPP_SHR(8)>(0.f, v);
    const float t0 = rl_f(v, 15), t1 = rl_f(v, 31), t2 = rl_f(v, 47);
    const float add = (lane >= 48) ? (t0 + t1) + t2 : (lane >= 32) ? t0 + t1 : (lane >= 16) ? t0 : 0.f;
    return v + add; }
__device__ __forceinline__ float wave_scan_max(float v, int lane) {
    const float ninf = -INFINITY;
    v = fmaxf(v, dpp_f<DPP_SHR(1)>(ninf, v)); v = fmaxf(v, dpp_f<DPP_SHR(2)>(ninf, v)); v = fmaxf(v, dpp_f<DPP_SHR(4)>(ninf, v)); v = fmaxf(v, dpp_f<DPP_SHR(8)>(ninf, v));
    const float t0 = rl_f(v, 15), t1 = rl_f(v, 31), t2 = rl_f(v, 47);
    const float mx = (lane >= 48) ? fmaxf(fmaxf(t0, t1), t2) : (lane >= 32) ? fmaxf(t0, t1) : (lane >= 16) ? t0 : ninf;
    return fmaxf(v, mx); }

#define XB_TMO      128
#define XB_XCNT(j)  (256  + 64 * (j))
#define XB_XSUB(j)  (1280 + 64 * (j))
#define XB_XGEN(j)  (2304 + 64 * (j))
#define XB_TOP      3328
#define XB_TOPGEN   3392
#define XCD_BAR_WORDS 3456
#define XB_SPIN_CAP (1u << 20)
__device__ __forceinline__ unsigned xb_ld(unsigned* p)              { return __hip_atomic_load(p, __ATOMIC_RELAXED, __HIP_MEMORY_SCOPE_AGENT); }
__device__ __forceinline__ unsigned xb_add(unsigned* p, unsigned v) { return __hip_atomic_fetch_add(p, v, __ATOMIC_RELAXED, __HIP_MEMORY_SCOPE_AGENT); }
__device__ __forceinline__ unsigned xb_xcc_id() { return (unsigned)__builtin_amdgcn_s_getreg((3 << 11) | 20) & 0xFu; }
#define XB_SPIN(cond, bar) do { unsigned _sp = 0; while (cond) { __builtin_amdgcn_s_sleep(1); \
    if ((++_sp & 255u) == 0u) { if (xb_ld(&(bar)[XB_TMO])) break; if (_sp > XB_SPIN_CAP) { atomicAdd(&(bar)[XB_TMO], 1u); break; } } } } while (0)
struct XcdBarrier { unsigned* bar; unsigned x; volatile LAS unsigned* st; };
__device__ __forceinline__ XcdBarrier xcd_barrier_post(unsigned* bar, volatile LAS unsigned* st) {
    XcdBarrier b; b.bar = bar; b.x = xb_xcc_id(); b.st = st;
    if (threadIdx.x == 0) (void)xb_add(&bar[XB_XCNT(b.x)], 1u);
    return b;
}
__device__ __forceinline__ void xcd_barrier_complete(unsigned* bar, unsigned x, unsigned& nloc, unsigned& nx) {
    const unsigned G = gridDim.x * gridDim.y * gridDim.z;
    unsigned sum, cnt, mine, sp = 0u;
    for (;;) {
        sum = 0u; cnt = 0u; mine = 0u;
#pragma unroll
        for (unsigned j = 0; j < 16; ++j) { const unsigned c = xb_ld(&bar[XB_XCNT(j)]); sum += c; cnt += (c > 0u) ? 1u : 0u; mine = (j == x) ? c : mine; }
        if (sum == G) break;
        __builtin_amdgcn_s_sleep(1);
        if ((++sp & 255u) == 0u) { if (xb_ld(&bar[XB_TMO])) break; if (sp > XB_SPIN_CAP) { atomicAdd(&bar[XB_TMO], 1u); break; } }
    }
    nloc = mine > 0u ? mine : 1u; nx = cnt > 0u ? cnt : 1u;
}
__device__ __forceinline__ void xcd_barrier(const XcdBarrier& b) {
    asm volatile("s_waitcnt vmcnt(0)" ::: "memory");
    __syncthreads();
    if (threadIdx.x == 0) {
        unsigned* bar = b.bar;
        __builtin_amdgcn_s_waitcnt(0);
        unsigned nloc = b.st[0], nx = b.st[1];
        if (nloc == 0u) { xcd_barrier_complete(bar, b.x, nloc, nx); b.st[0] = nloc; b.st[1] = nx; }
        const unsigned old = xb_add(&bar[XB_XSUB(b.x)], 1u);
        const unsigned gen = old / nloc;
        if (old + 1u == (gen + 1u) * nloc) {
            __builtin_amdgcn_fence(__ATOMIC_RELEASE, "agent");
            asm volatile("s_waitcnt vmcnt(0)" ::: "memory");
            const unsigned og = xb_add(&bar[XB_TOP], 1u);
            const unsigned tg = og / nx;
            if (og + 1u == (tg + 1u) * nx) xb_add(&bar[XB_TOPGEN], 1u);
            else XB_SPIN(xb_ld(&bar[XB_TOPGEN]) == tg, bar);
            __builtin_amdgcn_fence(__ATOMIC_ACQUIRE, "agent");
            xb_add(&bar[XB_XGEN(b.x)], 1u);
            asm volatile("s_waitcnt vmcnt(0)" ::: "memory");
        } else {
            XB_SPIN(xb_ld(&bar[XB_XGEN(b.x)]) == gen, bar);
            __builtin_amdgcn_fence(__ATOMIC_ACQUIRE, "agent");
            asm volatile("s_waitcnt vmcnt(0)" ::: "memory");
        }
    }
    __syncthreads();
}

namespace pg8 {
constexpr int BM = 256, BK = 64, HALF = 128, HTB = HALF * BK * 2, STAGE_BYTES = 8 * HTB, NXCD = 8, WGM = 8;
__device__ __forceinline__ int lds_byte(int r, int c) { const int st = (r >> 4) * 2 + (c >> 5), rr = r & 15, cc = c & 31, ob = rr * 64 + cc * 2; return st * 1024 + (ob ^ (((ob >> 9) & 1) << 5)); }
__device__ __forceinline__ void stage_rc(int b, int& R, int& C) { const int st = b / 1024, sb = b % 1024, swz = sb ^ (((sb >> 9) & 1) << 5); R = (st >> 1) * 16 + swz / 64; C = (st & 1) * 32 + (swz % 64) / 2; }
__device__ __forceinline__ int perm32(int rho) { const int n = rho >> 4, i = rho & 15; return 8 * (i >> 2) + 4 * n + (i & 3); }
struct Unit { int pm, pn, seg; };

template <class Epi, class Sched>
__device__ __forceinline__ void gemm_phase(LAS unsigned char* lds, const int K, const Sched& S, const Epi& E) {
    const int tid = threadIdx.x, wid = __builtin_amdgcn_readfirstlane(tid >> 6), lane = tid & 63, wr = wid >> 2, wc = wid & 3, fr = lane & 15, fq = lane >> 4;
    const int nt = K / BK;
    unsigned voffA[2], voffB[2];
#pragma unroll
    for (int i = 0; i < 2; ++i) { int R, C; stage_rc(tid * 16 + i * 8192, R, C); const int Rb = Epi::PERM ? ((R & ~31) + perm32(R & 31)) : R;
        voffA[i] = (unsigned)(R * K + C) * 2u; voffB[i] = (unsigned)(Rb * K + C) * 2u; }
    const size_t kstep = (size_t)(BK * 2);
    const size_t hstep = (size_t)HALF * K * 2;
    const unsigned ldsw = (unsigned)wid * 1024u;
    const int aoff = lds_byte(wr * 64 + fr, fq * 8), boff = lds_byte(wc * 32 + fr, fq * 8);
#define PG8_SA(b, h) (((b) * 2 + (h)) * HTB)
#define PG8_SB(b, h) ((4 + (b) * 2 + (h)) * HTB)
#define PG8_STAGE(bufoff, gbase, voff) do { _Pragma("unroll") for (int _i = 0; _i < 2; ++_i) \
        __builtin_amdgcn_global_load_lds((const unsigned*)((const char*)(gbase) + (voff)[_i]), (LAS unsigned*)(lds + (bufoff) + ldsw + _i * 8192), 16, 0, 0); } while (0)
#define PG8_LDA(dst, b, h) do { _Pragma("unroll") for (int m = 0; m < 4; ++m) _Pragma("unroll") for (int k = 0; k < 2; ++k) dst[m][k] = *(const LAS bf16x8*)(lds + PG8_SA(b, h) + aoff + m * 2048 + k * 1024); } while (0)
#define PG8_LDB(dst, b, h) do { _Pragma("unroll") for (int n = 0; n < 2; ++n) _Pragma("unroll") for (int k = 0; k < 2; ++k) dst[n][k] = *(const LAS bf16x8*)(lds + PG8_SB(b, h) + boff + n * 2048 + k * 1024); } while (0)
#define PG8_MMA(ai, bj, At, Bt) do { __builtin_amdgcn_s_setprio(1); _Pragma("unroll") for (int m = 0; m < 4; ++m) _Pragma("unroll") for (int n = 0; n < 2; ++n) _Pragma("unroll") for (int k = 0; k < 2; ++k) \
        acc[ai][bj][m][n] = __builtin_amdgcn_mfma_f32_16x16x32_bf16(Bt[n][k], At[m][k], acc[ai][bj][m][n], 0, 0, 0); __builtin_amdgcn_s_setprio(0); } while (0)
#define PG8_WAIT_V(n) asm volatile("s_waitcnt vmcnt(" #n ")" ::: "memory")
#define PG8_WAIT_L(n) asm volatile("s_waitcnt lgkmcnt(" #n ")" ::: "memory")
#define PG8_BAR __builtin_amdgcn_s_barrier()
#define PG8_SCHED __builtin_amdgcn_sched_barrier(0)
    Unit cur, nxt; int ui = 0;
    if (!S.next(0, cur)) return;
    f32x4 acc[2][2][4][2];
#pragma unroll
    for (int a = 0; a < 2; ++a)
#pragma unroll
        for (int b = 0; b < 2; ++b)
#pragma unroll
            for (int m = 0; m < 4; ++m)
#pragma unroll
                for (int n = 0; n < 2; ++n) acc[a][b][m][n] = (f32x4){0.f, 0.f, 0.f, 0.f};
    bf16x8 At[4][2], B0[2][2], B1[2][2];
    const char* cA = S.abase(cur); const char* cB = S.bbase(cur);
    PG8_STAGE(PG8_SB(0, 0), cB, voffB); PG8_STAGE(PG8_SA(0, 0), cA, voffA); PG8_STAGE(PG8_SB(0, 1), cB + hstep, voffB); PG8_STAGE(PG8_SA(0, 1), cA + hstep, voffA);
    if (wr == 1) PG8_BAR;
    PG8_WAIT_V(4); PG8_BAR;
    PG8_STAGE(PG8_SB(1, 0), cB + kstep, voffB); PG8_STAGE(PG8_SA(1, 0), cA + kstep, voffA); PG8_STAGE(PG8_SB(1, 1), cB + hstep + kstep, voffB);
    PG8_WAIT_V(6); PG8_BAR;
    for (;;) {
        const bool has_next = S.next(ui + 1, nxt);
        const char* nA = has_next ? S.abase(nxt) : cA; const char* nB = has_next ? S.bbase(nxt) : cB;
        for (int t = 0; t < nt; t += 2) {
            const bool last = (t == nt - 2);
            const char* a1 = cA + (size_t)(t + 1) * kstep;
            const char* a2 = last ? nA : cA + (size_t)(t + 2) * kstep; const char* b2 = last ? nB : cB + (size_t)(t + 2) * kstep;
            const char* a3 = a2 + kstep; const char* b3 = b2 + kstep;
            PG8_LDB(B0, 0, 0); PG8_SCHED; PG8_LDA(At, 0, 0); PG8_STAGE(PG8_SA(1, 1), a1 + hstep, voffA);
            PG8_WAIT_L(8); PG8_BAR; PG8_WAIT_L(0); PG8_MMA(0, 0, At, B0); PG8_BAR; PG8_SCHED;
            PG8_LDB(B1, 0, 1); PG8_STAGE(PG8_SB(0, 0), b2, voffB);
            PG8_BAR; PG8_WAIT_L(0); PG8_MMA(0, 1, At, B1); PG8_BAR;
            PG8_LDA(At, 0, 1); PG8_STAGE(PG8_SA(0, 0), a2, voffA);
            PG8_BAR; PG8_WAIT_L(0); PG8_MMA(1, 0, At, B0); PG8_BAR; PG8_SCHED;
            PG8_STAGE(PG8_SB(0, 1), b2 + hstep, voffB);
            PG8_WAIT_V(6); PG8_BAR; PG8_MMA(1, 1, At, B1); PG8_BAR;
            PG8_LDB(B0, 1, 0); PG8_SCHED; PG8_LDA(At, 1, 0); PG8_STAGE(PG8_SA(0, 1), a2 + hstep, voffA);
            PG8_WAIT_L(8); PG8_BAR; PG8_WAIT_L(0); PG8_MMA(0, 0, At, B0); PG8_BAR; PG8_SCHED;
            PG8_LDB(B1, 1, 1); PG8_STAGE(PG8_SB(1, 0), b3, voffB);
            PG8_BAR; PG8_WAIT_L(0); PG8_MMA(0, 1, At, B1); PG8_BAR;
            PG8_LDA(At, 1, 1); PG8_STAGE(PG8_SA(1, 0), a3, voffA);
            PG8_BAR; PG8_WAIT_L(0); PG8_MMA(1, 0, At, B0); PG8_BAR; PG8_SCHED;
            PG8_STAGE(PG8_SB(1, 1), b3 + hstep, voffB);
            PG8_WAIT_V(6); PG8_BAR; PG8_MMA(1, 1, At, B1); PG8_BAR;
        }
        if constexpr (!Epi::AFTER_DRAIN) E(acc, cur, wr, wc, fr, fq);
        if (!has_next) break;
        if (E.zero_after(cur)) {
#pragma unroll
            for (int a = 0; a < 2; ++a)
#pragma unroll
                for (int b = 0; b < 2; ++b)
#pragma unroll
                    for (int m = 0; m < 4; ++m)
#pragma unroll
                        for (int n = 0; n < 2; ++n) acc[a][b][m][n] = (f32x4){0.f, 0.f, 0.f, 0.f};
        }
        cur = nxt; cA = nA; cB = nB; ++ui;
    }
    PG8_WAIT_V(0);
    if (wr == 0) PG8_BAR;
    PG8_BAR;
    if constexpr (Epi::AFTER_DRAIN) E(acc, cur, wr, wc, fr, fq);
#undef PG8_SA
#undef PG8_SB
#undef PG8_STAGE
#undef PG8_LDA
#undef PG8_LDB
#undef PG8_MMA
#undef PG8_WAIT_V
#undef PG8_WAIT_L
#undef PG8_BAR
#undef PG8_SCHED
}
}
using pg8::Unit;

struct SchedIn {
    int nN, pnoff, G, c; const char* A; const char* B;
    __device__ __forceinline__ bool next(int i, Unit& u) const {
        const int nM = 65, nwg = nM * nN; const long L = (long)i * G + c; if (L >= nwg) return false;
        int wgid = (int)L; { const int q = nwg / 8, r = nwg % 8, xcd = wgid % 8, off = wgid / 8; wgid = (xcd < r ? xcd * (q + 1) : r * (q + 1) + (xcd - r) * q) + off; }
        const int nig = 8 * nN, gid = wgid / nig, fm = gid * 8, gsz = (nM - fm) < 8 ? (nM - fm) : 8;
        u.pm = fm + ((wgid % nig) % gsz); u.pn = pnoff + (wgid % nig) / gsz; u.seg = 0; return true;
    }
    __device__ __forceinline__ const char* abase(const Unit& u) const { return A + (size_t)u.pm * (256 * 1024 * 2); }
    __device__ __forceinline__ const char* bbase(const Unit& u) const { return B + (size_t)u.pn * (256 * 1024 * 2); }
};
struct SchedMerge {
    int G, c; const char* A0; const char* A1; const char* B0; const char* B1;
    __device__ __forceinline__ bool next(int i, Unit& u) const {
        const int tile = (i >> 1) * G + c; if (tile >= 256) return false;
        u.pm = tile >> 2; u.pn = tile & 3; u.seg = i & 1; return true;
    }
    __device__ __forceinline__ const char* abase(const Unit& u) const { return (u.seg ? A1 : A0) + (size_t)u.pm * (256 * 2048 * 2); }
    __device__ __forceinline__ const char* bbase(const Unit& u) const { return (u.seg ? B1 : B0) + (size_t)u.pn * (256 * 2048 * 2); }
};
struct SchedOut {
    int G, c; const char* A; const char* B;
    __device__ __forceinline__ bool next(int i, Unit& u) const {
        const int tile = i * G + c; if (tile >= 256) return false;
        u.pm = tile >> 2; u.pn = tile & 3; u.seg = 0; return true;
    }
    __device__ __forceinline__ const char* abase(const Unit& u) const { return A + (size_t)u.pm * (256 * 1024 * 2); }
    __device__ __forceinline__ const char* bbase(const Unit& u) const { return B + (size_t)u.pn * (256 * 1024 * 2); }
};

struct EpiQKV {
    static constexpr bool AFTER_DRAIN = false;
    static constexpr bool PERM = true;
    bf16_t* QB; bf16_t* KB; bf16_t* VB;
    __device__ __forceinline__ bool zero_after(const Unit&) const { return true; }
    __device__ __forceinline__ void operator()(f32x4 (&acc)[2][2][4][2], const Unit& u, int wr, int wc, int fr, int fq) const {
        bf16_t* base; int ldc, colt; float sc = 1.f;
        if (u.pn < 4) { base = QB; ldc = 1024; colt = u.pn * 256; sc = 0.0625f; }
        else if (u.pn < 8) { base = KB; ldc = 1024; colt = (u.pn - 4) * 256; }
        else { base = VB; ldc = 2048; colt = (u.pn - 8) * 256; }
        const int row0 = u.pm * 256 + wr * 64 + fr, col0 = colt + wc * 32 + 8 * fq;
#pragma unroll
        for (int ai = 0; ai < 2; ++ai)
#pragma unroll
            for (int m = 0; m < 4; ++m) { bf16_t* rowp = base + (size_t)(row0 + ai * 128 + m * 16) * ldc + col0;
#pragma unroll
                for (int bj = 0; bj < 2; ++bj) { const f32x4 v0 = acc[ai][bj][m][0] * sc, v1 = acc[ai][bj][m][1] * sc;
                    u32x4 w; w.x = cvt_pk_bf16(v0[0], v0[1]); w.y = cvt_pk_bf16(v0[2], v0[3]); w.z = cvt_pk_bf16(v1[0], v1[1]); w.w = cvt_pk_bf16(v1[2], v1[3]);
                    *(u32x4*)(rowp + bj * 128) = w; } }
    }
};
struct EpiRest {
    static constexpr bool AFTER_DRAIN = false;
    static constexpr bool PERM = true;
    bf16_t* HN; const float* SC; const float* mhw; const float* convw; bf16_t* UB; bf16_t* UF; bf16_t* GSB; bf16_t* GS; bf16_t* GG;
    __device__ __forceinline__ bool zero_after(const Unit&) const { return true; }
    __device__ __forceinline__ void operator()(f32x4 (&acc)[2][2][4][2], const Unit& u, int wr, int wc, int fr, int fq) const {
        const int row0 = u.pm * 256 + wr * 64 + fr; const int cw = wc * 32 + 8 * fq;
        if (u.pn >= 64) {
            const int col0 = (u.pn - 64) * 256 + cw;
#pragma unroll
            for (int ai = 0; ai < 2; ++ai)
#pragma unroll
                for (int m = 0; m < 4; ++m) { const int r = row0 + ai * 128 + m * 16, b = r / LP, p = r - b * LP; if (p < 64) continue;
                    bf16_t* rowp = GG + (size_t)(b * SEQ + p - 64) * 2048 + col0;
#pragma unroll
                    for (int bj = 0; bj < 2; ++bj) { const f32x4 v0 = acc[ai][bj][m][0], v1 = acc[ai][bj][m][1];
                        u32x4 w; w.x = cvt_pk_bf16(v0[0], v0[1]); w.y = cvt_pk_bf16(v0[2], v0[3]); w.z = cvt_pk_bf16(v1[0], v1[1]); w.w = cvt_pk_bf16(v1[2], v1[3]);
                        *(u32x4*)(rowp + bj * 128) = w; } }
            return;
        }
        if (u.pn >= 32) {
            const int chl = 64 * (u.pn - 32) + 16 * wc + 4 * fq;
            const f32x4 cw0 = *(const f32x4*)(convw + chl), cw1 = *(const f32x4*)(convw + 2048 + chl), cw2 = *(const f32x4*)(convw + 4096 + chl);
            asm volatile("" :: "v"(cw0), "v"(cw1), "v"(cw2));
            f32x4 uu[2][4];
#pragma unroll
            for (int ai = 0; ai < 2; ++ai)
#pragma unroll
                for (int m = 0; m < 4; ++m) uu[ai][m] = acc[ai][0][m][0] * acc[ai][0][m][1];
#pragma unroll
            for (int ai = 0; ai < 2; ++ai)
#pragma unroll
                for (int m = 0; m < 4; ++m) {
                    const int r = row0 + ai * 128 + m * 16, b = r / LP, p = r - b * LP; const size_t cr = (size_t)(b * SEQ + p - 64);
                    const f32x4 cur = uu[ai][m], sb = acc[ai][1][m][0], zs = acc[ai][1][m][1];
                    f32x4 u1, u2, gs;
#pragma unroll
                    for (int jj = 0; jj < 4; ++jj) {
                        const float s1 = dpp_f<DPP_SHR(1)>(0.f, cur[jj]), s2 = dpp_f<DPP_SHR(2)>(0.f, cur[jj]);
                        float r1 = 0.f, r2 = 0.f;
                        if (m > 0) { const float pv = uu[ai][m > 0 ? m - 1 : 0][jj]; r1 = dpp_f<DPP_ROR(1)>(pv, pv); r2 = dpp_f<DPP_ROR(2)>(pv, pv); }
                        u1[jj] = (fr >= 1) ? s1 : r1; u2[jj] = (fr >= 2) ? s2 : r2;
                        gs[jj] = zs[jj] * sigm(zs[jj]) * sb[jj];
                    }
                    const size_t grp = (size_t)(r >> 6);
                    if (m == 0 && fr < 2) {
                        *(u32x2*)(UF + (grp * 2 + fr) * 2048 + chl) = (u32x2){cvt_pk_bf16(cur[0], cur[1]), cvt_pk_bf16(cur[2], cur[3])};
                        *(u32x2*)(GSB + (grp * 2 + fr) * 2048 + chl) = (u32x2){cvt_pk_bf16(gs[0], gs[1]), cvt_pk_bf16(gs[2], gs[3])};
                    } else if (p >= 64) {
                        f32x4 y;
#pragma unroll
                        for (int jj = 0; jj < 4; ++jj) y[jj] = gs[jj] * (cw0[jj] * u2[jj] + cw1[jj] * u1[jj] + cw2[jj] * cur[jj]);
                        *(u32x2*)(GS + cr * 2048 + chl) = (u32x2){cvt_pk_bf16(y[0], y[1]), cvt_pk_bf16(y[2], y[3])};
                    }
                    if (m == 3 && fr >= 14) *(u32x2*)(UB + (grp * 2 + fr - 14) * 2048 + chl) = (u32x2){cvt_pk_bf16(cur[0], cur[1]), cvt_pk_bf16(cur[2], cur[3])};
                }
            return;
        }
        const int ch0 = (u.pn - 16) * 128 + cw;
        float mw[8];
#pragma unroll
        for (int j = 0; j < 8; ++j) mw[j] = mhw[ch0 + j];
        u32x4 hnv[2][4]; float scv[2][4];
#pragma unroll
        for (int ai = 0; ai < 2; ++ai)
#pragma unroll
            for (int m = 0; m < 4; ++m) { const int r = row0 + ai * 128 + m * 16, b = r / LP, p = r - b * LP; const size_t cr = (p >= 64) ? (size_t)(b * SEQ + p - 64) : 0;
                hnv[ai][m] = *(const u32x4*)(HN + cr * 2048 + ch0); scv[ai][m] = SC[cr * 4 + (ch0 >> 9)]; }
#pragma unroll
        for (int ai = 0; ai < 2; ++ai)
#pragma unroll
            for (int m = 0; m < 4; ++m) {
                const int r = row0 + ai * 128 + m * 16, b = r / LP, p = r - b * LP; const size_t cr = (size_t)(b * SEQ + p - 64);
                float v[8];
                const u32x4 hn = hnv[ai][m]; const float sc = scv[ai][m];
                const float hv[8] = {bf_lo(hn.x), bf_hi(hn.x), bf_lo(hn.y), bf_hi(hn.y), bf_lo(hn.z), bf_hi(hn.z), bf_lo(hn.w), bf_hi(hn.w)};
#pragma unroll
                for (int j = 0; j < 8; ++j) { const float o = acc[ai][0][m][j >> 2][j & 3], z = acc[ai][1][m][j >> 2][j & 3]; v[j] = z * __builtin_amdgcn_rcpf((1.0f + enu(z)) * (1.0f + en(o))) * (hv[j] * sc * mw[j]); }
                u32x4 w; w.x = cvt_pk_bf16(v[0], v[1]); w.y = cvt_pk_bf16(v[2], v[3]); w.z = cvt_pk_bf16(v[4], v[5]); w.w = cvt_pk_bf16(v[6], v[7]);
                if (p >= 64) *(u32x4*)(HN + cr * 2048 + ch0) = w;
            }
    }
};
struct EpiMerge {
    static constexpr bool AFTER_DRAIN = false;
    static constexpr bool PERM = true;
    const bf16_t* GG; bf16_t* MG;
    __device__ __forceinline__ bool zero_after(const Unit& u) const { return u.seg == 1; }
    __device__ __forceinline__ void operator()(f32x4 (&acc)[2][2][4][2], const Unit& u, int wr, int wc, int fr, int fq) const {
        const int row0 = u.pm * 256 + wr * 64 + fr, col0 = u.pn * 256 + wc * 32 + 8 * fq;
#pragma unroll
        for (int ai = 0; ai < 2; ++ai) {
            u32x4 gaq[4][2], gbq[4][2];
#pragma unroll
            for (int m = 0; m < 4; ++m) { const size_t cr = (size_t)(row0 + ai * 128 + m * 16);
#pragma unroll
                for (int bj = 0; bj < 2; ++bj) { gbq[m][bj] = *(const u32x4*)(GG + cr * 2048 + 1024 + col0 + bj * 128);
                    gaq[m][bj] = (u.seg == 0) ? *(const u32x4*)(GG + cr * 2048 + col0 + bj * 128) : gbq[m][bj]; } }
#pragma unroll
            for (int m = 0; m < 4; ++m) { const size_t cr = (size_t)(row0 + ai * 128 + m * 16);
#pragma unroll
                for (int bj = 0; bj < 2; ++bj) {
                    const u32x4 ga = gaq[m][bj], gb = gbq[m][bj];
                    const float gav[8] = {bf_lo(ga.x), bf_hi(ga.x), bf_lo(ga.y), bf_hi(ga.y), bf_lo(ga.z), bf_hi(ga.z), bf_lo(ga.w), bf_hi(ga.w)};
                    const float gbv[8] = {bf_lo(gb.x), bf_hi(gb.x), bf_lo(gb.y), bf_hi(gb.y), bf_lo(gb.z), bf_hi(gb.z), bf_lo(gb.w), bf_hi(gb.w)};
                    if (u.seg == 0) {
#pragma unroll
                        for (int j = 0; j < 8; ++j) acc[ai][bj][m][j >> 2][j & 3] *= (1.0f + en(gbv[j])) * __builtin_amdgcn_rcpf(1.0f + en(gav[j]));
                    } else {
                        float v[8];
#pragma unroll
                        for (int j = 0; j < 8; ++j) v[j] = acc[ai][bj][m][j >> 2][j & 3] * __builtin_amdgcn_rcpf(1.0f + en(gbv[j]));
                        u32x4 w; w.x = cvt_pk_bf16(v[0], v[1]); w.y = cvt_pk_bf16(v[2], v[3]); w.z = cvt_pk_bf16(v[4], v[5]); w.w = cvt_pk_bf16(v[6], v[7]);
                        *(u32x4*)(MG + cr * 1024 + col0 + bj * 128) = w;
                    }
                } }
        }
    }
};
struct EpiOut {
    static constexpr bool PERM = false, AFTER_DRAIN = true;
    const float* x; float* out; float* SSQ; unsigned* cnt; const float* fw; unsigned* tmo;
    __device__ __forceinline__ bool zero_after(const Unit&) const { return true; }
    __device__ __forceinline__ void operator()(f32x4 (&acc)[2][2][4][2], const Unit& u, int wr, int wc, int fr, int fq) const {
        const int row0 = u.pm * 256 + wr * 64 + fr, col0 = u.pn * 256 + wc * 32 + 4 * fq;
#pragma unroll
        for (int ai = 0; ai < 2; ++ai)
#pragma unroll
            for (int m = 0; m < 4; ++m) { const size_t cr = (size_t)(row0 + ai * 128 + m * 16); float ss = 0.f;
#pragma unroll
                for (int bj = 0; bj < 2; ++bj)
#pragma unroll
                    for (int n = 0; n < 2; ++n) { const size_t o = cr * 1024 + col0 + bj * 128 + n * 16;
                        const f32x4 h = *(const f32x4*)(x + o) + acc[ai][bj][m][n]; acc[ai][bj][m][n] = h;
                        ss += (h[0] * h[0] + h[1] * h[1]) + (h[2] * h[2] + h[3] * h[3]); }
                ss += __shfl_xor(ss, 16); ss += __shfl_xor(ss, 32);
                if (fq == 0) __hip_atomic_store(SSQ + cr * 16 + u.pn * 4 + wc, ss, __ATOMIC_RELAXED, __HIP_MEMORY_SCOPE_AGENT); }
        asm volatile("s_waitcnt vmcnt(0)" ::: "memory");
        __syncthreads();
        if (threadIdx.x == 0) {
            __hip_atomic_fetch_add(cnt + 64 * u.pm, 1u, __ATOMIC_RELAXED, __HIP_MEMORY_SCOPE_AGENT);
            unsigned sp = 0;
            while (__hip_atomic_load(cnt + 64 * u.pm, __ATOMIC_RELAXED, __HIP_MEMORY_SCOPE_AGENT) < 4u) {
                __builtin_amdgcn_s_sleep(1);
                if (++sp > (1u << 22)) { __hip_atomic_store(tmo, 1u, __ATOMIC_RELAXED, __HIP_MEMORY_SCOPE_AGENT); break; } }
            __builtin_amdgcn_fence(__ATOMIC_ACQUIRE, "agent");
            asm volatile("s_waitcnt vmcnt(0)" ::: "memory");
        }
        __syncthreads();
        f32x4 wv[2][2];
#pragma unroll
        for (int bj = 0; bj < 2; ++bj)
#pragma unroll
            for (int n = 0; n < 2; ++n) wv[bj][n] = *(const f32x4*)(fw + col0 + bj * 128 + n * 16);
#pragma unroll
        for (int ai = 0; ai < 2; ++ai)
#pragma unroll
            for (int m = 0; m < 4; ++m) { const size_t cr = (size_t)(row0 + ai * 128 + m * 16);
                const f32x4 s0 = __builtin_nontemporal_load((const f32x4*)(SSQ + cr * 16)), s1 = __builtin_nontemporal_load((const f32x4*)(SSQ + cr * 16 + 4)),
                            s2 = __builtin_nontemporal_load((const f32x4*)(SSQ + cr * 16 + 8)), s3 = __builtin_nontemporal_load((const f32x4*)(SSQ + cr * 16 + 12));
                const f32x4 st = (s0 + s1) + (s2 + s3);
                const float rs = rsqrtf(((st[0] + st[1]) + (st[2] + st[3])) * (1.0f / 1024.0f) + EPS);
#pragma unroll
                for (int bj = 0; bj < 2; ++bj)
#pragma unroll
                    for (int n = 0; n < 2; ++n) { const size_t o = cr * 1024 + col0 + bj * 128 + n * 16; const f32x4 h = acc[ai][bj][m][n];
                        *(f32x4*)(out + o) = (f32x4){h[0] * rs * wv[bj][n][0], h[1] * rs * wv[bj][n][1], h[2] * rs * wv[bj][n][2], h[3] * rs * wv[bj][n][3]}; } }
    }
};
struct EpiOutPlain {
    static constexpr bool PERM = false, AFTER_DRAIN = false;
    const float* x; float* out; float* SSQ;
    __device__ __forceinline__ bool zero_after(const Unit&) const { return true; }
    __device__ __forceinline__ void operator()(f32x4 (&acc)[2][2][4][2], const Unit& u, int wr, int wc, int fr, int fq) const {
        const int row0 = u.pm * 256 + wr * 64 + fr, col0 = u.pn * 256 + wc * 32 + 4 * fq;
#pragma unroll
        for (int ai = 0; ai < 2; ++ai)
#pragma unroll
            for (int m = 0; m < 4; ++m) { const size_t cr = (size_t)(row0 + ai * 128 + m * 16); float ss = 0.f;
#pragma unroll
                for (int bj = 0; bj < 2; ++bj)
#pragma unroll
                    for (int n = 0; n < 2; ++n) { const size_t o = cr * 1024 + col0 + bj * 128 + n * 16;
                        const f32x4 h = *(const f32x4*)(x + o) + acc[ai][bj][m][n]; *(f32x4*)(out + o) = h;
                        ss += (h[0] * h[0] + h[1] * h[1]) + (h[2] * h[2] + h[3] * h[3]); }
                ss += __shfl_xor(ss, 16); ss += __shfl_xor(ss, 32);
                if (fq == 0) SSQ[cr * 16 + u.pn * 4 + wc] = ss; }
    }
};

__device__ __forceinline__ int win_col(int np) {
    const int pn = np >> 8, l = np & 255, bj = l >> 7, w = l & 127;
    if (pn < 16) return np;
    if (pn < 32) return (bj ? OFF_ZA : OFF_O) + 128 * (pn - 16) + w;
    if (pn < 64) {
        const int wc = (l >> 5) & 3, fq = (l >> 3) & 3, n = (l >> 2) & 1, jj = l & 3, q = bj * 2 + n;
        const int off = q == 0 ? OFF_SH : q == 1 ? OFF_SC : q == 2 ? OFF_SB : OFF_ZS;
        return off + 64 * (pn - 32) + 16 * wc + 4 * fq + jj; }
    if (pn < 68) return OFF_GA + 256 * (pn - 64) + l;
    return OFF_GB + 256 * (pn - 68) + l;
}
__device__ void phase_prep(LAS unsigned char* lds, const Args& a) {
    const int tid = threadIdx.x, wid = tid >> 6, lane = tid & 63;
    LAS float* tile = (LAS float*)lds;
    LAS float* wg = (LAS float*)(lds + 256 * 65 * 4);
    bf16_t* WINT = (bf16_t*)(a.ws + WS_WINT); bf16_t* WAT = (bf16_t*)(a.ws + WS_WAT); bf16_t* WBT = (bf16_t*)(a.ws + WS_WBT); bf16_t* WOT = (bf16_t*)(a.ws + WS_WOT);
#define TR_DECODE(job, src, dst, lds_, col0, n0, k0, Kd) \
        if (job < 1152) { const int jn = job >> 2, jk = job & 3; n0 = jn * 64; k0 = jk * 256; src = a.w_in; lds_ = NIN; col0 = win_col(n0); dst = WINT; Kd = 1024; } \
        else if (job < 1408) { const int j = job - 1152, which = j >> 7, jj = j & 127, jn = jj >> 3, jk = jj & 7; n0 = jn * 64; k0 = jk * 256; src = which ? a.w_pb : a.w_pa; lds_ = 1024; col0 = n0; dst = which ? WBT : WAT; Kd = 2048; } \
        else { const int j = job - 1408, jn = j >> 2, jk = j & 3; n0 = jn * 64; k0 = jk * 256; src = a.w_out; lds_ = 1024; col0 = n0; dst = WOT; Kd = 1024; }
    {
        f32x4 v[8];
        int job = blockIdx.x;
        if (job < 1472) { const float* src; bf16_t* dst; int lds_, col0, n0, k0, Kd; TR_DECODE(job, src, dst, lds_, col0, n0, k0, Kd); (void)dst; (void)Kd;
#pragma unroll
            for (int i = 0; i < 8; ++i) { const int idx = tid + 512 * i, kr = idx >> 4, c4 = idx & 15; v[i] = *(const f32x4*)(src + (size_t)(k0 + kr) * lds_ + (job < 1152 ? win_col(n0 + 4 * c4) : col0 + 4 * c4)); } }
        for (; job < 1472; job += gridDim.x) {
            const float* src; bf16_t* dst; int lds_, col0, n0, k0, Kd; TR_DECODE(job, src, dst, lds_, col0, n0, k0, Kd); (void)src; (void)lds_; (void)col0;
#pragma unroll
            for (int i = 0; i < 8; ++i) { const int idx = tid + 512 * i, kr = idx >> 4, c4 = idx & 15;
                tile[kr * 65 + 4 * c4 + 0] = v[i][0]; tile[kr * 65 + 4 * c4 + 1] = v[i][1]; tile[kr * 65 + 4 * c4 + 2] = v[i][2]; tile[kr * 65 + 4 * c4 + 3] = v[i][3]; }
            const int nj = job + gridDim.x;
            if (nj < 1472) { const float* src2; bf16_t* dst2; int lds2, col2, n2, k2, Kd2; TR_DECODE(nj, src2, dst2, lds2, col2, n2, k2, Kd2); (void)dst2; (void)Kd2;
#pragma unroll
                for (int i = 0; i < 8; ++i) { const int idx = tid + 512 * i, kr = idx >> 4, c4 = idx & 15; v[i] = *(const f32x4*)(src2 + (size_t)(k2 + kr) * lds2 + (nj < 1152 ? win_col(n2 + 4 * c4) : col2 + 4 * c4)); } }
            __syncthreads();
            { const int n = tid >> 3, seg = tid & 7;
#pragma unroll
              for (int kq = 0; kq < 4; ++kq) { float f[8];
#pragma unroll
                for (int j = 0; j < 8; ++j) f[j] = tile[(64 * kq + 8 * seg + j) * 65 + n];
                u32x4 w; w.x = cvt_pk_bf16(f[0], f[1]); w.y = cvt_pk_bf16(f[2], f[3]); w.z = cvt_pk_bf16(f[4], f[5]); w.w = cvt_pk_bf16(f[6], f[7]);
                *(u32x4*)(dst + (size_t)(n0 + n) * Kd + k0 + 64 * kq + 8 * seg) = w; } }
            __syncthreads();
        }
    }
#undef TR_DECODE
    for (int i = tid; i < 8192; i += 512) wg[i] = a.w_in[(size_t)(i >> 3) * NIN + OFF_I + (i & 7)];
    __syncthreads();
    bf16_t* XN = (bf16_t*)(a.ws + WS_XN); float* LI = (float*)(a.ws + WS_LI); float* LF = (float*)(a.ws + WS_LF);
    for (int r = blockIdx.x * 8 + wid; r < MP; r += gridDim.x * 8) {
        const int b = r / LP, p = r - b * LP;
        if (p < PADL) {
#pragma unroll
            for (int i = 0; i < 4; ++i) *(u32x2*)(XN + (size_t)r * 1024 + 256 * i + 4 * lane) = (u32x2){0u, 0u};
            if (lane < 4) { LI[(b * 4 + lane) * LP + p] = -INFINITY; LF[(b * 4 + lane) * LP + p] = 0.f; }
            continue;
        }
        const int pos = p - PADL;
        const float* src = pos < 16 ? a.meta + (size_t)pos * 1024 : a.x + ((size_t)b * SEQ + pos - 16) * 1024;
        f32x4 xv[4]; float ss = 0.f;
#pragma unroll
        for (int i = 0; i < 4; ++i) { xv[i] = *(const f32x4*)(src + 256 * i + 4 * lane); ss += (xv[i][0] * xv[i][0] + xv[i][1] * xv[i][1]) + (xv[i][2] * xv[i][2] + xv[i][3] * xv[i][3]); }
        ss = wave_sum(ss);
        const float rs = rsqrtf(ss * (1.0f / 1024.0f) + EPS);
        float g[8] = {0.f, 0.f, 0.f, 0.f, 0.f, 0.f, 0.f, 0.f};
#pragma unroll
        for (int i = 0; i < 4; ++i) { const f32x4 nw = *(const f32x4*)(a.norm_w + 256 * i + 4 * lane);
            f32x4 y; y[0] = xv[i][0] * rs * nw[0]; y[1] = xv[i][1] * rs * nw[1]; y[2] = xv[i][2] * rs * nw[2]; y[3] = xv[i][3] * rs * nw[3];
            *(u32x2*)(XN + (size_t)r * 1024 + 256 * i + 4 * lane) = (u32x2){cvt_pk_bf16(y[0], y[1]), cvt_pk_bf16(y[2], y[3])};
#pragma unroll
            for (int j = 0; j < 4; ++j) { const int k = 256 * i + 4 * lane + j; const f32x4 w0 = *(const LAS f32x4*)(wg + k * 8), w1 = *(const LAS f32x4*)(wg + k * 8 + 4);
                g[0] += y[j] * w0[0]; g[1] += y[j] * w0[1]; g[2] += y[j] * w0[2]; g[3] += y[j] * w0[3]; g[4] += y[j] * w1[0]; g[5] += y[j] * w1[1]; g[6] += y[j] * w1[2]; g[7] += y[j] * w1[3]; } }
#pragma unroll
        for (int j = 0; j < 8; ++j) g[j] = wave_sum(g[j]);
        if (lane < 4) {
            const float ip = (lane == 0 ? g[0] : lane == 1 ? g[1] : lane == 2 ? g[2] : g[3]) + a.b_i[lane];
            const float fp = (lane == 0 ? g[4] : lane == 1 ? g[5] : lane == 2 ? g[6] : g[7]) + a.b_f[lane];
            const float li = 15.0f * tanhf(ip * (1.0f / 15.0f));
            const float fc = 15.0f * tanhf(fp * (1.0f / 15.0f));
            const float lf = fminf(fc, 0.f) - log1pf(expf(-fabsf(fc)));
            LI[(b * 4 + lane) * LP + p] = li; LF[(b * 4 + lane) * LP + p] = lf;
        }
    }
}


__device__ void gate_summaries(const Args& a) {
    const int wid = threadIdx.x >> 6, lane = threadIdx.x & 63;
    const float* LI = (const float*)(a.ws + WS_LI); const float* LF = (const float*)(a.ws + WS_LF); float* SUM = (float*)(a.ws + WS_SUM);
    for (int j = blockIdx.x * 8 + wid; j < NITEM; j += gridDim.x * 8) {
        const int bh = j / NCH, c = j - bh * NCH;
        const float lf = LF[bh * LP + 64 * c + lane], li = LI[bh * LP + 64 * c + lane];
        const float bc = wave_scan_add(lf, lane); const float bl = __shfl(bc, 63); const float av = wave_max(bl - bc + li);
        if (lane == 0) { SUM[2 * j] = bl; SUM[2 * j + 1] = av; }
    }
}

__device__ void phase_prepass(LAS unsigned char* lds, const Args& a) {
    const int tid = threadIdx.x, wid = tid >> 6, lane = tid & 63, e16 = lane & 15, g = lane >> 4;
    LAS float* sm = (LAS float*)lds;
    const bf16_t* QB = (const bf16_t*)(a.ws + WS_R1); const bf16_t* KB = QB + (size_t)MP * 1024;
    const float* LI = (const float*)(a.ws + WS_LI); const float* LF = (const float*)(a.ws + WS_LF); const float* SUM = (const float*)(a.ws + WS_SUM);
    float* EMT = (float*)(a.ws + WS_EMT); float* DECAY = (float*)(a.ws + WS_DECAY); float* KWSUM = (float*)(a.ws + WS_KWS); float* RW = (float*)(a.ws + WS_RW);
    bf16_t* QF = (bf16_t*)(a.ws + WS_R3); bf16_t* KWTF = QF + (size_t)NITEM * 16384; bf16_t* WF = KWTF + (size_t)NITEM * 16384;
    int par = 0;
    for (int item = blockIdx.x; item < NITEM; item += gridDim.x, par ^= 1) {
        const int bh = item / NCH, c = item - bh * NCH, b = bh >> 2, h = bh & 3;
        const size_t row0 = (size_t)b * LP + 64 * c;
        LAS float* kws = sm + 320 + par * 320; LAS float* rw = kws + 256;
        if (tid < 256) kws[tid] = 0.f;
        if (tid >= 256 && tid < 320) rw[tid - 256] = 0.f;
        const int tt = wid >> 1;
        f32x4 acc[2];
        {
            bf16x8 qa[8], kb[2][8];
            const bf16_t* qp = QB + (row0 + 16 * tt + e16) * 1024 + h * 256 + 8 * g;
#pragma unroll
            for (int kk = 0; kk < 8; ++kk) qa[kk] = *(const bf16x8*)(qp + 32 * kk);
#pragma unroll
            for (int q = 0; q < 2; ++q) { const int st = (wid & 1) * 2 + q; const bf16_t* kp = KB + (row0 + 16 * st + e16) * 1024 + h * 256 + 8 * g;
#pragma unroll
                for (int kk = 0; kk < 8; ++kk) kb[q][kk] = *(const bf16x8*)(kp + 32 * kk); }
            asm volatile("" : "+v"(qa[0]), "+v"(qa[7]), "+v"(kb[0][0]), "+v"(kb[1][7]));
#pragma unroll
            for (int q = 0; q < 2; ++q) { acc[q] = (f32x4){0.f, 0.f, 0.f, 0.f};
#pragma unroll
                for (int kk = 0; kk < 8; ++kk) acc[q] = __builtin_amdgcn_mfma_f32_16x16x32_bf16(qa[kk], kb[q][kk], acc[q], 0, 0, 0); }
        }
        if (wid == 1) {
            const float* lip = LI + bh * LP; const float* lfp = LF + bh * LP;
            float B = (lane < c) ? SUM[2 * (bh * NCH + lane)] : 0.f, A = (lane < c) ? SUM[2 * (bh * NCH + lane) + 1] : -INFINITY;
            const float lf = lfp[64 * c + lane], li = lip[64 * c + lane];
#pragma unroll
            for (int o = 1; o < 64; o <<= 1) { const float Bp = __shfl_up(B, o), Ap = __shfl_up(A, o); if (lane >= o) { A = fmaxf(Ap + B, A); B = Bp + B; } }
            float mprev = 0.f;
            if (c > 0) { const float mB = __shfl(B, c - 1), mA = __shfl(A, c - 1); mprev = fmaxf(mB, mA); }
            const float bc = wave_scan_add(lf, lane);
            const float pm = wave_scan_max(li - bc, lane);
            const float mm = fmaxf(mprev, pm), mt = bc + mm, wi = __expf(mprev - mm);
            const float bl = __shfl(bc, 63), mnew = __shfl(mt, 63);
            const float kw = __expf(bl - bc + li - mnew);
            sm[lane] = bc; sm[64 + lane] = li; sm[128 + lane] = mt; sm[192 + lane] = wi; sm[256 + lane] = kw;
            EMT[bh * LP + 64 * c + lane] = __expf(-mt);
            if (lane == 63) DECAY[item] = wi;
        }
        __syncthreads();
        if (c > 0)
#pragma unroll
        for (int q = 0; q < 2; ++q) {
            const int st = (wid & 1) * 2 + q;
            const int s = 16 * st + e16; const float bs = sm[s], lis = sm[64 + s];
#pragma unroll
            for (int r = 0; r < 4; ++r) { const int t = 16 * tt + 4 * g + r;
                float v = 0.f;
                if (s <= t) v = __expf(sm[t] - bs + lis - sm[128 + t]) * acc[q][r];
                const int ks = s >> 5, lp = (t & 15) + 16 * ((s & 31) >> 3), j = s & 7;
                WF[(size_t)item * 4096 + ((tt * 2 + ks) * 64 + lp) * 8 + j] = (bf16_t)(cvt_pk_bf16(v, 0.f) & 0xffffu);
                const float rs = row_sum16(v);
                if (e16 == 0 && st <= tt) __hip_atomic_fetch_add(rw + t, rs, __ATOMIC_RELAXED, __HIP_MEMORY_SCOPE_WORKGROUP); }
        }
        {
            u32x2 qlo[4], qhi[4]; unsigned short kraw[4][8];
#pragma unroll
            for (int i = 0; i < 4; ++i) {
                const int slot = tid + 512 * i, lp = slot & 63, ft = slot >> 6, le = lp & 15, lg = lp >> 4;
                if (c > 0) { const int kk = ft >> 2, tq = ft & 3, t = 16 * tq + le;
                    const bf16_t* qp = QB + (row0 + t) * 1024 + h * 256 + 32 * kk + 4 * lg; qlo[i] = *(const u32x2*)qp; qhi[i] = *(const u32x2*)(qp + 16); }
                else { qlo[i] = (u32x2){0u, 0u}; qhi[i] = (u32x2){0u, 0u}; }
                { const int ks = ft & 1, d = 16 * (ft >> 1) + le;
#pragma unroll
                  for (int j = 0; j < 8; ++j) kraw[i][j] = KB[(row0 + 32 * ks + 8 * lg + j) * 1024 + h * 256 + d]; }
            }
#pragma unroll
            for (int i = 0; i < 4; ++i) {
                const int slot = tid + 512 * i, lp = slot & 63, ft = slot >> 6, le = lp & 15, lg = lp >> 4;
                if (c > 0) { const int tq = ft & 3, t = 16 * tq + le; const float wi = sm[192 + t]; const u32x2 lo = qlo[i], hi = qhi[i];
                    u32x4 w; w.x = cvt_pk_bf16(bf_lo(lo.x) * wi, bf_hi(lo.x) * wi); w.y = cvt_pk_bf16(bf_lo(lo.y) * wi, bf_hi(lo.y) * wi);
                    w.z = cvt_pk_bf16(bf_lo(hi.x) * wi, bf_hi(hi.x) * wi); w.w = cvt_pk_bf16(bf_lo(hi.y) * wi, bf_hi(hi.y) * wi);
                    *(u32x4*)(QF + (size_t)item * 16384 + (size_t)slot * 8) = w; }
                { const int ks = ft & 1, d = 16 * (ft >> 1) + le; float f[8];
#pragma unroll
                  for (int j = 0; j < 8; ++j) f[j] = sm[256 + 32 * ks + 8 * lg + j] * bf2f(kraw[i][j]);
                  u32x4 w; w.x = cvt_pk_bf16(f[0], f[1]); w.y = cvt_pk_bf16(f[2], f[3]); w.z = cvt_pk_bf16(f[4], f[5]); w.w = cvt_pk_bf16(f[6], f[7]);
                  *(u32x4*)(KWTF + (size_t)item * 16384 + (size_t)slot * 8) = w;
                  float ssum = ((f[0] + f[1]) + (f[2] + f[3])) + ((f[4] + f[5]) + (f[6] + f[7]));
                  ssum += __shfl_xor(ssum, 16); ssum += __shfl_xor(ssum, 32);
                  if (lg == 0) __hip_atomic_fetch_add(kws + d, ssum, __ATOMIC_RELAXED, __HIP_MEMORY_SCOPE_WORKGROUP); }
            }
        }
        __syncthreads();
        if (tid < 256) KWSUM[(size_t)item * 256 + tid] = kws[tid];
        if (tid >= 256 && tid < 320) RW[(size_t)item * 64 + tid - 256] = rw[tid - 256];
    }
}

__device__ void phase_scan(LAS unsigned char* lds, const Args& a) {
    const int tid = threadIdx.x, wid = __builtin_amdgcn_readfirstlane(tid >> 6), lane = tid & 63, e16 = lane & 15, g = lane >> 4;
    LAS f32x4* red = (LAS f32x4*)lds;
    LAS unsigned char* vl = lds + 131072;
    LAS float* npv = (LAS float*)(lds + 131072 + 2 * 4608);
    LAS float* decl = (LAS float*)(lds + LDS_DEC_OFF);
    const bf16_t* VB = (const bf16_t*)(a.ws + WS_R2);
    const bf16_t* QF = (const bf16_t*)(a.ws + WS_R3); const bf16_t* KWTF = QF + (size_t)NITEM * 16384; const bf16_t* WF = KWTF + (size_t)NITEM * 16384;
    const float* DECAY = (const float*)(a.ws + WS_DECAY); const float* KWSUM = (const float*)(a.ws + WS_KWS); const float* RW = (const float*)(a.ws + WS_RW);
    bf16_t* HN = (bf16_t*)(a.ws + WS_R1); float* DEN = (float*)(a.ws + WS_DEN);
    const int G = gridDim.x; const int vc = (G == 256) ? (((int)blockIdx.x & 7) * 32 + ((int)blockIdx.x >> 3)) : (int)blockIdx.x;
    const int ttw = wid >> 1, ksw = wid & 1;
    for (int job = vc; job < 256; job += G) {
        const int bh = job >> 4, sl = job & 15, b = bh >> 2, h = bh & 3;
        if (tid >= 256 && tid < 256 + NCH) decl[tid - 256] = DECAY[bh * NCH + tid - 256];
        if (tid < 256) { float n = 0.f; float kv[NCH];
#pragma unroll
            for (int c = 0; c < NCH; ++c) kv[c] = KWSUM[(size_t)(bh * NCH + c) * 256 + tid];
#pragma unroll
            for (int c = 0; c < NCH; ++c) { if ((c & 15) == sl) npv[(c >> 4) * 256 + tid] = n; n = DECAY[bh * NCH + c] * n + kv[c]; } }
        __syncthreads();
        for (int ci = 0; 16 * ci + sl < NCH; ++ci) {
            const int c = 16 * ci + sl, item = bh * NCH + c, t = tid >> 3, kk = tid & 7; float dot = 0.f;
#pragma unroll
            for (int lg = 0; lg < 4; ++lg) { const u32x4 q = *(const u32x4*)(QF + (size_t)item * 16384 + ((kk * 4 + (t >> 4)) * 64 + (t & 15) + 16 * lg) * 8);
                const float qv[8] = {bf_lo(q.x), bf_hi(q.x), bf_lo(q.y), bf_hi(q.y), bf_lo(q.z), bf_hi(q.z), bf_lo(q.w), bf_hi(q.w)};
#pragma unroll
                for (int j = 0; j < 8; ++j) dot += qv[j] * npv[ci * 256 + 32 * kk + 16 * (j >> 2) + 4 * lg + (j & 3)]; }
            dot += __shfl_xor(dot, 1); dot += __shfl_xor(dot, 2); dot += __shfl_xor(dot, 4);
            if (kk == 0 && c >= 1) DEN[((size_t)b * SEQ + 64 * (c - 1) + t) * 4 + h] = dot + RW[(size_t)item * 64 + t];
        }
        f32x4 C[2][2];
#pragma unroll
        for (int i = 0; i < 2; ++i)
#pragma unroll
            for (int j = 0; j < 2; ++j) C[i][j] = (f32x4){0.f, 0.f, 0.f, 0.f};
        const int vrow = tid >> 3, vcq = tid & 7;
        struct OpSet { bf16x8 k[4], w; float d; };
        OpSet R0, R1; bf16x8 Q0[4], Q1[4], Q2[4]; u32x2 V0, V1, V2;
        const bf16_t* vgp = VB + ((size_t)b * LP + vrow) * 2048 + h * 512 + 32 * sl + 4 * vcq;
        const bf16_t* qgp = QF + (size_t)bh * NCH * 16384 + (wid * 256 + lane) * 8;
        const bf16_t* kgp = KWTF + (size_t)bh * NCH * 16384 + (wid * 256 + lane) * 8;
        const bf16_t* wgp = WF + (size_t)bh * NCH * 4096 + ((ttw * 2 + ksw) * 64 + lane) * 8;
        const unsigned vrd = (unsigned)(uintptr_t)(vl + (8 * g + ((lane & 15) >> 2)) * 72 + 8 * (lane & 3));
        const unsigned vwr = (unsigned)(vrow * 72 + vcq * 8);
#define SC_LOADK(R, cc) do { _Pragma("unroll") for (int i_ = 0; i_ < 4; ++i_) R.k[i_] = *(const bf16x8*)(kgp + (size_t)(cc) * 16384 + i_ * 512); \
            R.w = *(const bf16x8*)(wgp + (size_t)(cc) * 4096); \
            R.d = decl[(cc)]; } while (0)
#define SC_LOADQ(Q, V, cc) do { V = *(const u32x2*)(vgp + (size_t)(cc) * (64 * 2048)); \
            _Pragma("unroll") for (int tt_ = 0; tt_ < 4; ++tt_) Q[tt_] = *(const bf16x8*)(qgp + (size_t)(cc) * 16384 + tt_ * 512); } while (0)
#define SC_TR(dst, off) asm volatile("ds_read_b64_tr_b16 %0, %1 offset:%2" : "=&v"(dst) : "v"(vaddr), "i"(off) : "memory")
#define SC_STEP(c, CUR, NX, QC, QL, VN, VL) do { if ((c) < NCH) { \
            const int buf = (c) & 1; \
            if ((c) + 1 < NCH) SC_LOADK(NX, (c) + 1); \
            if ((c) + 2 < NCH) SC_LOADQ(QL, VL, (c) + 2); \
            union { u32x2 h[2]; bf16x8 v; } vfu[2][2]; \
            { const unsigned vaddr = vrd + buf * 4608; \
              SC_TR(vfu[0][0].h[0], 0); SC_TR(vfu[0][0].h[1], 288); SC_TR(vfu[0][1].h[0], 32); SC_TR(vfu[0][1].h[1], 320); \
              SC_TR(vfu[1][0].h[0], 2304); SC_TR(vfu[1][0].h[1], 2592); SC_TR(vfu[1][1].h[0], 2336); SC_TR(vfu[1][1].h[1], 2624); \
              asm volatile("s_waitcnt lgkmcnt(0)" ::: "memory"); } \
            bf16x8 cf[2]; \
            _Pragma("unroll") for (int et = 0; et < 2; ++et) { union { u32x4 u; bf16x8 v; } cu; \
                cu.u.x = cvt_pk_bf16(C[0][et][0], C[0][et][1]); cu.u.y = cvt_pk_bf16(C[0][et][2], C[0][et][3]); \
                cu.u.z = cvt_pk_bf16(C[1][et][0], C[1][et][1]); cu.u.w = cvt_pk_bf16(C[1][et][2], C[1][et][3]); cf[et] = cu.v; } \
            f32x4 num[4][2]; \
            _Pragma("unroll") for (int tt = 0; tt < 4; ++tt) _Pragma("unroll") for (int et = 0; et < 2; ++et) \
                num[tt][et] = __builtin_amdgcn_mfma_f32_16x16x32_bf16(QC[tt], cf[et], (f32x4){0.f, 0.f, 0.f, 0.f}, 0, 0, 0); \
            _Pragma("unroll") for (int tt = 0; tt < 4; ++tt) _Pragma("unroll") for (int ks = 0; ks < 2; ++ks) if (tt == ttw && ks == ksw) { \
                _Pragma("unroll") for (int et = 0; et < 2; ++et) num[tt][et] = __builtin_amdgcn_mfma_f32_16x16x32_bf16(CUR.w, vfu[ks][et].v, num[tt][et], 0, 0, 0); } \
            _Pragma("unroll") for (int dl = 0; dl < 2; ++dl) _Pragma("unroll") for (int et = 0; et < 2; ++et) { C[dl][et] = C[dl][et] * CUR.d; \
                _Pragma("unroll") for (int ks = 0; ks < 2; ++ks) C[dl][et] = __builtin_amdgcn_mfma_f32_16x16x32_bf16(CUR.k[dl * 2 + ks], vfu[ks][et].v, C[dl][et], 0, 0, 0); } \
            _Pragma("unroll") for (int tt = 0; tt < 4; ++tt) _Pragma("unroll") for (int et = 0; et < 2; ++et) red[((buf * 8 + wid) * 8 + tt * 2 + et) * 64 + lane] = num[tt][et]; \
            if ((c) + 1 < NCH) *(LAS u32x2*)(vl + (buf ^ 1) * 4608 + vwr) = VN; \
            asm volatile("s_waitcnt lgkmcnt(0)" ::: "memory"); __builtin_amdgcn_s_barrier(); asm volatile("" ::: "memory"); \
            if ((c) >= 1) { \
                f32x4 tot = red[((buf * 8 + 0) * 8 + wid) * 64 + lane]; \
                _Pragma("unroll") for (int w2 = 1; w2 < 8; ++w2) tot += red[((buf * 8 + w2) * 8 + wid) * 64 + lane]; \
                const size_t cr0 = (size_t)b * SEQ + 64 * ((c) - 1) + 16 * ttw + 4 * g; \
                bf16_t* hp = HN + cr0 * 2048 + h * 512 + 32 * sl + 16 * ksw + e16; \
                _Pragma("unroll") for (int r = 0; r < 4; ++r) hp[(size_t)r * 2048] = (bf16_t)(cvt_pk_bf16(tot[r], 0.f) & 0xffffu); } \
        } } while (0)
        SC_LOADK(R0, 0); SC_LOADQ(Q0, V0, 0); SC_LOADQ(Q1, V1, 1);
        *(LAS u32x2*)(vl + vwr) = V0;
        __syncthreads();
        for (int c0 = 0; c0 < NCH; c0 += 6) {
            SC_STEP(c0,     R0, R1, Q0, Q2, V1, V2);
            SC_STEP(c0 + 1, R1, R0, Q1, Q0, V2, V0);
            SC_STEP(c0 + 2, R0, R1, Q2, Q1, V0, V1);
            SC_STEP(c0 + 3, R1, R0, Q0, Q2, V1, V2);
            SC_STEP(c0 + 4, R0, R1, Q1, Q0, V2, V0);
            SC_STEP(c0 + 5, R1, R0, Q2, Q1, V0, V1);
        }
#undef SC_LOADK
#undef SC_LOADQ
#undef SC_STEP
#undef SC_TR
        __syncthreads();
    }
}

__device__ void phase_stats(const Args& a) {
    const int wid = threadIdx.x >> 6, lane = threadIdx.x & 63;
    const bf16_t* HN = (const bf16_t*)(a.ws + WS_R1); const float* DEN = (const float*)(a.ws + WS_DEN); const float* EMT = (const float*)(a.ws + WS_EMT); float* SC = (float*)(a.ws + WS_SC);
    for (int cr = blockIdx.x * 8 + wid; cr < MC; cr += gridDim.x * 8) {
        const int b = cr >> 12, s = cr & 4095;
        u32x4 hv[4];
#pragma unroll
        for (int h = 0; h < 4; ++h) hv[h] = *(const u32x4*)(HN + (size_t)cr * 2048 + h * 512 + 8 * lane);
        const f32x4 den = *(const f32x4*)(DEN + (size_t)cr * 4);
        float em[4];
#pragma unroll
        for (int h = 0; h < 4; ++h) em[h] = EMT[(b * 4 + h) * LP + 64 + s];
        float res[4];
#pragma unroll
        for (int h = 0; h < 4; ++h) {
            const float inv = 1.0f / fmaxf(fabsf(den[h]), em[h]);
            const float f[8] = {bf_lo(hv[h].x), bf_hi(hv[h].x), bf_lo(hv[h].y), bf_hi(hv[h].y), bf_lo(hv[h].z), bf_hi(hv[h].z), bf_lo(hv[h].w), bf_hi(hv[h].w)};
            float ss = 0.f;
#pragma unroll
            for (int j = 0; j < 8; ++j) { const float v = f[j] * inv; ss += v * v; }
            ss = wave_sum(ss);
            res[h] = rsqrtf(ss * (1.0f / 512.0f) + EPS) * inv;
        }
        if (lane == 0) *(f32x4*)(SC + (size_t)cr * 4) = (f32x4){res[0], res[1], res[2], res[3]};
    }
}

__device__ __forceinline__ void conv_fix(const Args& a, int G, int i, size_t cr, int ch) {
    const bf16_t* UB = (const bf16_t*)(a.ws + WS_R3); const bf16_t* UF = UB + (size_t)260 * 2 * 2048; const bf16_t* GSB = UF + (size_t)260 * 2 * 2048; bf16_t* YS = (bf16_t*)(a.ws + WS_R2);
    const u32x4 u0 = *(const u32x4*)(UF + ((size_t)G * 2 + i) * 2048 + ch), gs = *(const u32x4*)(GSB + ((size_t)G * 2 + i) * 2048 + ch);
    const u32x4 u1 = i ? *(const u32x4*)(UF + ((size_t)G * 2) * 2048 + ch) : *(const u32x4*)(UB + ((size_t)(G - 1) * 2 + 1) * 2048 + ch);
    const u32x4 u2 = i ? *(const u32x4*)(UB + ((size_t)(G - 1) * 2 + 1) * 2048 + ch) : *(const u32x4*)(UB + ((size_t)(G - 1) * 2) * 2048 + ch);
    const unsigned u0w[4] = {u0.x, u0.y, u0.z, u0.w}, u1w[4] = {u1.x, u1.y, u1.z, u1.w}, u2w[4] = {u2.x, u2.y, u2.z, u2.w}, gw[4] = {gs.x, gs.y, gs.z, gs.w};
    unsigned ow[4];
#pragma unroll
    for (int q = 0; q < 4; ++q) { const int c0 = ch + 2 * q;
        const float ya = bf_lo(gw[q]) * (a.conv_w[c0] * bf_lo(u2w[q]) + a.conv_w[2048 + c0] * bf_lo(u1w[q]) + a.conv_w[4096 + c0] * bf_lo(u0w[q]));
        const float yb = bf_hi(gw[q]) * (a.conv_w[c0 + 1] * bf_hi(u2w[q]) + a.conv_w[2048 + c0 + 1] * bf_hi(u1w[q]) + a.conv_w[4096 + c0 + 1] * bf_hi(u0w[q]));
        ow[q] = cvt_pk_bf16(ya, yb); }
    *(u32x4*)(YS + cr * 2048 + ch) = (u32x4){ow[0], ow[1], ow[2], ow[3]};
}
__device__ void phase_conv(const Args& a) {
    const int wid = threadIdx.x >> 6, lane = threadIdx.x & 63;
    for (int job = blockIdx.x * 8 + wid; job < 260 * 8; job += gridDim.x * 8) {
        const int G = job >> 3, i = (job >> 2) & 1, it = job & 3;
        const int b = (64 * G) / LP, p0 = 64 * G - b * LP; if (p0 < 64) continue;
        conv_fix(a, G, i, (size_t)b * SEQ + p0 - 64 + i, 512 * it + 8 * lane);
    }
}
__device__ void conv_fix_panel(const Args& a, int pm) {
    const int r8 = threadIdx.x >> 6, lane = threadIdx.x & 63, k = r8 >> 1, i = r8 & 1;
    const int b = pm >> 4, s0 = 256 * (pm & 15) + 64 * k, G = b * NCH + 1 + (s0 >> 6);
#pragma unroll
    for (int it = 0; it < 4; ++it) conv_fix(a, G, i, (size_t)b * SEQ + s0 + i, 512 * it + 8 * lane);
    asm volatile("s_waitcnt vmcnt(0)" ::: "memory");
    __syncthreads();
}

__device__ void phase_final(const Args& a) {
    const int wid = threadIdx.x >> 6, lane = threadIdx.x & 63;
    const float* SSQ = (const float*)(a.ws + WS_SSQ);
    f32x4 w[4];
#pragma unroll
    for (int i = 0; i < 4; ++i) w[i] = *(const f32x4*)(a.fin_w + 256 * i + 4 * lane);
    for (int cr = (blockIdx.x * 8 + wid) * 2; cr < MC; cr += gridDim.x * 16) {
        f32x4 v[2][4]; float ss[2];
#pragma unroll
        for (int q = 0; q < 2; ++q) { ss[q] = (lane < 16) ? SSQ[(size_t)(cr + q) * 16 + lane] : 0.f;
#pragma unroll
            for (int i = 0; i < 4; ++i) v[q][i] = *(const f32x4*)(a.out + (size_t)(cr + q) * 1024 + 256 * i + 4 * lane); }
#pragma unroll
        for (int q = 0; q < 2; ++q) { const float rs = rsqrtf(wave_sum(ss[q]) * (1.0f / 1024.0f) + EPS);
#pragma unroll
            for (int i = 0; i < 4; ++i) *(f32x4*)(a.out + (size_t)(cr + q) * 1024 + 256 * i + 4 * lane) = (f32x4){v[q][i][0] * rs * w[i][0], v[q][i][1] * rs * w[i][1], v[q][i][2] * rs * w[i][2], v[q][i][3] * rs * w[i][3]}; }
    }
}

__global__ void __launch_bounds__(512, 2) fwd(Args a) {
    extern __shared__ __attribute__((aligned(16))) unsigned char lds_raw[];
    LAS unsigned char* lds = (LAS unsigned char*)lds_raw;
    cg::grid_group grid = cg::this_grid();
    const int lo = a.ph_lo, hi = a.ph_hi; const int G = gridDim.x, c = blockIdx.x;
    if (lo < 0) grid.sync();
    volatile LAS unsigned* bst = (volatile LAS unsigned*)(lds + LDS_BAR_OFF);
    if (threadIdx.x == 0) { bst[0] = 0u; bst[1] = 0u; }
    __syncthreads();
    XcdBarrier xbar; xbar.bar = (unsigned*)(a.ws + WS_BAR); xbar.x = 0; xbar.st = bst;
    if (hi - lo > 1) xbar = xcd_barrier_post((unsigned*)(a.ws + WS_BAR), bst);
#define GSYNC() xcd_barrier(xbar)
#define IN(k) (lo <= (k) && (k) < hi)
#if PROBE_A >= 0
    unsigned long long* TS = (unsigned long long*)(a.ws + WS_DECAY + 4160);
#define STAMP(k) do { if (blockIdx.x == 0 && threadIdx.x == 0) TS[k] = __builtin_amdgcn_s_memrealtime(); } while (0)
#else
#define STAMP(k) do { } while (0)
#endif
#define SEAM(k) do { if (IN(k) && IN((k) + 1)) GSYNC(); STAMP((k) + 1); } while (0)
    STAMP(0);
    if (IN(0)) phase_prep(lds, a);
    SEAM(0);
    if (IN(1)) { gate_summaries(a);
        SchedIn S{16, 0, G, c, (const char*)(a.ws + WS_XN), (const char*)(a.ws + WS_WINT)};
        EpiQKV E{(bf16_t*)(a.ws + WS_R1), (bf16_t*)(a.ws + WS_R1) + (size_t)MP * 1024, (bf16_t*)(a.ws + WS_R2)};
        pg8::gemm_phase(lds, 1024, S, E); }
    SEAM(1);
    if (IN(2)) phase_prepass(lds, a);
    SEAM(2);
    if (IN(3)) phase_scan(lds, a);
    SEAM(3);
    if (IN(4)) phase_stats(a);
    SEAM(4);
    if (IN(5)) { SchedIn S{56, 16, G, c, (const char*)(a.ws + WS_XN), (const char*)(a.ws + WS_WINT)};
        EpiRest E{(bf16_t*)(a.ws + WS_R1), (const float*)(a.ws + WS_SC), a.mh_w, a.conv_w, (bf16_t*)(a.ws + WS_R3), (bf16_t*)(a.ws + WS_R3) + (size_t)260 * 2 * 2048, (bf16_t*)(a.ws + WS_R3) + (size_t)260 * 4 * 2048, (bf16_t*)(a.ws + WS_R2), (bf16_t*)a.out};
        pg8::gemm_phase(lds, 1024, S, E); }
    SEAM(5);
    const bool fuse67 = IN(6) && IN(7);
    if (!fuse67) { if (IN(6)) phase_conv(a);
        SEAM(6); }
    if (IN(7)) { const int vc = (G == 256) ? ((c & 7) * 32 + (c >> 3)) : c;
        if (fuse67) { for (int tile = vc; tile < 256; tile += G) conv_fix_panel(a, tile >> 2); }
        SchedMerge S{G, vc, (const char*)(a.ws + WS_R1), (const char*)(a.ws + WS_R2), (const char*)(a.ws + WS_WAT), (const char*)(a.ws + WS_WBT)};
        EpiMerge E{(const bf16_t*)a.out, (bf16_t*)(a.ws + WS_XN)};
        pg8::gemm_phase(lds, 2048, S, E); }
    SEAM(7);
    const bool fuse89 = (G == 256) && IN(8) && IN(9);
    if (IN(8)) { const int vc = (G == 256) ? ((c & 7) * 32 + (c >> 3)) : c;
        SchedOut S{G, vc, (const char*)(a.ws + WS_XN), (const char*)(a.ws + WS_WOT)};
        if (fuse89) { EpiOut E{a.x, a.out, (float*)(a.ws + WS_SSQ), (unsigned*)(a.ws + WS_BAR) + XCD_BAR_WORDS + 64, a.fin_w, (unsigned*)(a.ws + WS_BAR) + XB_TMO};
            pg8::gemm_phase(lds, 1024, S, E); }
        else { EpiOutPlain E{a.x, a.out, (float*)(a.ws + WS_SSQ)};
            pg8::gemm_phase(lds, 1024, S, E); } }
    if (!fuse89) { SEAM(8);
        if (IN(9)) phase_final(a); }
#if PROBE_A >= 0
    GSYNC(); STAMP(10); GSYNC();
    { const float ta = (float)(TS[PROBE_A + 1] - TS[PROBE_A]) * 0.01f, tb = (float)(TS[PROBE_B + 1] - TS[PROBE_B]) * 0.01f;
      for (int i = blockIdx.x * 512 + threadIdx.x; i < (1 << 20); i += gridDim.x * 512) a.out[1024 + i] = tb * (1.0f / 32.0f);
      if (blockIdx.x == 0 && threadIdx.x == 0) a.out[0] = ta; }
#endif
#undef IN
#undef SEAM
}

constexpr int NPH = 10;


extern "C" void kernel_launch(void* const* d_in, const int* in_sizes, int n_in, void* d_out, int out_size, void* d_ws, size_t ws_size, hipStream_t stream) {
    static int grid = 0;
    if (grid == 0) {
        int dev = 0, cus = 0, per_cu = 0;
        (void)hipGetDevice(&dev);
        (void)hipDeviceGetAttribute(&cus, hipDeviceAttributeMultiprocessorCount, dev);
        if (hipFuncSetAttribute((const void*)fwd, hipFuncAttributeMaxDynamicSharedMemorySize, LDS_BYTES) != hipSuccess) { fprintf(stderr, "hipFuncSetAttribute failed\n"); grid = -1; return; }
        (void)hipOccupancyMaxActiveBlocksPerMultiprocessor(&per_cu, (const void*)fwd, 512, LDS_BYTES);
        (void)hipGetLastError();
        if (per_cu < 1) per_cu = 1;
        grid = cus * 1;
        if (ws_size < WS_END) fprintf(stderr, "kernel_launch: workspace too small: %zu < %zu\n", ws_size, (size_t)WS_END);
    }
    if (grid < 0) return;
    Args a{};
    a.x = (const float*)d_in[0]; a.meta = (const float*)d_in[1]; a.norm_w = (const float*)d_in[2]; a.w_in = (const float*)d_in[3];
    a.b_i = (const float*)d_in[4]; a.b_f = (const float*)d_in[5]; a.mh_w = (const float*)d_in[6]; a.conv_w = (const float*)d_in[7];
    a.w_pa = (const float*)d_in[8]; a.w_pb = (const float*)d_in[9]; a.w_out = (const float*)d_in[10]; a.fin_w = (const float*)d_in[11];
    a.out = (float*)d_out; a.ws = (unsigned char*)d_ws;
#if SINGLE_LAUNCH
    (void)hipMemsetAsync((unsigned char*)d_ws + WS_BAR, 0, 32768, stream);
    a.ph_lo = 0; a.ph_hi = NPH;
    void* args[] = {&a};
    hipError_t e = hipLaunchCooperativeKernel((const void*)fwd, dim3(grid), dim3(512), args, LDS_BYTES, stream);
    if (e != hipSuccess) fprintf(stderr, "cooperative launch failed: %s (grid %d)\n", hipGetErrorString(e), grid);
#else
    for (int k = 0; k < NPH; ++k) { a.ph_lo = k; a.ph_hi = k + 1; for (int rep = 0; rep < 1 + ((DBL_MASK >> k) & 1); ++rep) hipLaunchKernelGGL(fwd, dim3(grid), dim3(512), LDS_BYTES, stream, a); }
#endif
}
```
